# Optimizing an MI355X kernel written in HIP

```python
import math
import jax, jax.numpy as jnp
from jax import lax
import numpy as np

D_MODEL = 2048
BATCH = 4
SEQ = 4096
DEPTH = 2

NSA_HEADS = 16
NSA_KV_GROUPS = 4
NSA_HEAD_DIM = 64
NSA_CMP_LEN = 32
NSA_CMP_STRIDE = 16
NSA_CMP_HIDDEN = 256
NSA_SEL_LEN = 64
NSA_SEL_BLOCKS = 16
NSA_WINDOW = 512
DSA_HEADS = 16
DSA_HEAD_DIM = 64
DSA_KV_LATENT = 256
IDX_HEADS = 16
IDX_DIM = 32
DSA_TOPK_MAX = 256
INDEX_SCALE = (IDX_HEADS * IDX_DIM) ** -0.5
D_FF = 5632
REL_BUCKETS = 32
REL_MAX_DIST = 128
TOTAL_HEADS = NSA_HEADS + DSA_HEADS
Q_BLOCK = 128
N_SUBLAYERS = 3
ADA_INIT = 0.5
RMS_EPS = 1e-6
NEG_INF = -1e30
FORCE_BONUS = 1e4

NSA_KV_WIDTH = NSA_KV_GROUPS * NSA_HEAD_DIM
IN_SPLITS = (
    NSA_HEADS * NSA_HEAD_DIM,
    NSA_KV_WIDTH, NSA_KV_WIDTH,
    NSA_KV_WIDTH, NSA_KV_WIDTH,
    NSA_KV_WIDTH, NSA_KV_WIDTH,
    NSA_HEADS * 3,
    DSA_HEADS * DSA_HEAD_DIM,
    DSA_KV_LATENT,
    IDX_HEADS * IDX_DIM,
    IDX_DIM,
    IDX_HEADS,
    2 * D_MODEL,
)
N_IN = sum(IN_SPLITS)

kernel_name = "hybrid_nsa_dsa_macaron_adaln"


def _rmsnorm(x, g):
    xf = x.astype(jnp.float32)
    y = xf * lax.rsqrt(jnp.mean(xf * xf, axis=-1, keepdims=True) + RMS_EPS)
    return (y * g.astype(jnp.float32)).astype(x.dtype)


def _masked_softmax(s, mask):
    s = jnp.where(mask, s.astype(jnp.float32), NEG_INF)
    m = jnp.max(s, axis=-1, keepdims=True)
    p = jnp.where(mask, jnp.exp(s - m), 0.0)
    return p / jnp.maximum(jnp.sum(p, axis=-1, keepdims=True), 1e-30)


def _t5_bucket(dist):
    n = jnp.maximum(dist, 0)
    exact = REL_BUCKETS // 2
    nf = jnp.maximum(n, 1).astype(jnp.float32)
    large = exact + (jnp.log(nf / exact) / math.log(REL_MAX_DIST / exact)
                     * (REL_BUCKETS - exact)).astype(jnp.int32)
    large = jnp.minimum(large, REL_BUCKETS - 1)
    return jnp.where(n < exact, n, large)


def _to_blocks(a):
    b, s = a.shape[:2]
    return jnp.moveaxis(a.reshape(b, s // Q_BLOCK, Q_BLOCK, *a.shape[2:]), 1, 0)


def _from_blocks(o):
    nq, b, qb, f = o.shape
    return jnp.moveaxis(o, 0, 1).reshape(b, nq * qb, f)


def _swiglu(h, w_i, w_o):
    g, u = jnp.split(h @ w_i, 2, axis=-1)
    return (jax.nn.silu(g) * u) @ w_o


def _modulate(x, g, m):
    return _rmsnorm(x, g) * (1.0 + m[:, 1][:, None, :]) + m[:, 0][:, None, :]


def _nsa(q, kc, vc, ks, vs, kw, vw, gates, pe_k, pe_v, wk1, wk2, wv1, wv2, rel_bias):
    B, S = q.shape[:2]
    H, G, DK = NSA_HEADS, NSA_KV_GROUPS, NSA_HEAD_DIM
    HG = H // G
    scale = DK ** -0.5
    f32 = jnp.float32

    n_cmp = (S - NSA_CMP_LEN) // NSA_CMP_STRIDE + 1
    cmp_start = (np.arange(n_cmp) * NSA_CMP_STRIDE).astype(np.int32)
    blk_idx = cmp_start[:, None] + np.arange(NSA_CMP_LEN, dtype=np.int32)[None, :]
    cmp_end = jnp.asarray(cmp_start + NSA_CMP_LEN - 1)

    def compress(t, pe, w1, w2):
        blocks = jnp.moveaxis(t[:, blk_idx], 3, 2) + pe
        flat = blocks.reshape(B, n_cmp, G, NSA_CMP_LEN * DK)
        return jax.nn.silu(flat @ w1) @ w2

    k_cmp = compress(kc, pe_k, wk1, wk2)
    v_cmp = compress(vc, pe_v, wv1, wv2)

    n_blk = S // NSA_SEL_LEN
    n_sel = min(NSA_SEL_BLOCKS, n_blk)
    sel_start = np.arange(n_blk) * NSA_SEL_LEN
    overlap = jnp.asarray(((cmp_start[:, None] < sel_start[None, :] + NSA_SEL_LEN)
                           & (cmp_start[:, None] + NSA_CMP_LEN > sel_start[None, :])).astype(np.float32))
    k_sb = ks.reshape(B, n_blk, NSA_SEL_LEN, G, DK).transpose(0, 3, 1, 2, 4)
    v_sb = vs.reshape(B, n_blk, NSA_SEL_LEN, G, DK).transpose(0, 3, 1, 2, 4)

    pad = ((0, 0), (NSA_WINDOW, 0), (0, 0), (0, 0))
    kw_pad = jnp.pad(kw, pad)
    vw_pad = jnp.pad(vw, pad)
    table_n = rel_bias[:, :H]
    table_g = table_n.reshape(REL_BUCKETS, G, HG)
    wq = jnp.arange(Q_BLOCK)
    wk = jnp.arange(Q_BLOCK + NSA_WINDOW)
    off_w = wq[:, None] - wk[None, :] + NSA_WINDOW
    bias_w = table_n[_t5_bucket(off_w)].reshape(Q_BLOCK, Q_BLOCK + NSA_WINDOW, G, HG).transpose(0, 2, 3, 1)
    mask_w_rel = (off_w >= 0) & (off_w < NSA_WINDOW)
    bidx = jnp.arange(B)[:, None, None, None]
    gidx = jnp.arange(G)[None, None, :, None]
    blk = jnp.arange(n_blk)

    def block(args):
        i, qb, gb = args
        t = i * Q_BLOCK + wq
        qg = qb.reshape(B, Q_BLOCK, G, HG, DK)
        gg = gb.reshape(B, Q_BLOCK, G, HG, 3)

        dist_c = t[:, None] - cmp_end[None, :]
        bias_c = table_n[_t5_bucket(dist_c)].reshape(Q_BLOCK, n_cmp, G, HG).transpose(0, 2, 3, 1)
        s_c = jnp.einsum('btghd,bngd->btghn', qg, k_cmp).astype(f32) * scale + bias_c
        p_c = _masked_softmax(s_c, (dist_c >= 0)[:, None, None, :])
        o_c = jnp.einsum('btghn,bngd->btghd', p_c.astype(v_cmp.dtype), v_cmp)

        imp = jnp.einsum('btghn,nj->btgj', p_c, overlap)
        cur = t // NSA_SEL_LEN
        forced = (blk[None, :] == 0) | (blk[None, :] == cur[:, None]) | (blk[None, :] == cur[:, None] - 1)
        visible = blk[None, :] * NSA_SEL_LEN <= t[:, None]
        imp = jnp.where(visible[None, :, None, :],
                        imp + jnp.where(forced, FORCE_BONUS, 0.0)[None, :, None, :], NEG_INF)
        _, sel = lax.top_k(imp, n_sel)
        n_tok = n_sel * NSA_SEL_LEN
        k_g = k_sb[bidx, gidx, sel].reshape(B, Q_BLOCK, G, n_tok, DK)
        v_g = v_sb[bidx, gidx, sel].reshape(B, Q_BLOCK, G, n_tok, DK)
        pos = (sel[..., None] * NSA_SEL_LEN + jnp.arange(NSA_SEL_LEN)).reshape(B, Q_BLOCK, G, n_tok)
        dist_s = t[None, :, None, None] - pos
        bias_s = jnp.moveaxis(table_g[_t5_bucket(dist_s), gidx], -1, 3)
        s_s = jnp.einsum('btghd,btgkd->btghk', qg, k_g).astype(f32) * scale + bias_s
        p_s = _masked_softmax(s_s, (dist_s >= 0)[:, :, :, None, :])
        o_s = jnp.einsum('btghk,btgkd->btghd', p_s.astype(v_g.dtype), v_g)

        k_wb = lax.dynamic_slice_in_dim(kw_pad, i * Q_BLOCK, Q_BLOCK + NSA_WINDOW, axis=1)
        v_wb = lax.dynamic_slice_in_dim(vw_pad, i * Q_BLOCK, Q_BLOCK + NSA_WINDOW, axis=1)
        mask_w = mask_w_rel & ((i * Q_BLOCK - NSA_WINDOW + wk) >= 0)[None, :]
        s_w = jnp.einsum('btghd,bsgd->btghs', qg, k_wb).astype(f32) * scale + bias_w
        p_w = _masked_softmax(s_w, mask_w[:, None, None, :])
        o_w = jnp.einsum('btghs,bsgd->btghd', p_w.astype(v_wb.dtype), v_wb)

        o = gg[..., 0:1] * o_c + gg[..., 1:2] * o_s + gg[..., 2:3] * o_w
        return o.reshape(B, Q_BLOCK, H * DK)

    nq = S // Q_BLOCK
    out = lax.map(block, (jnp.arange(nq), _to_blocks(q), _to_blocks(gates)))
    return _from_blocks(out)


def _dsa(q, ckv, qi, ki, wi, w_uk, w_uv, rel_bias):
    B, S = q.shape[:2]
    k_top = min(DSA_TOPK_MAX, S // 4)
    scale = DSA_HEAD_DIM ** -0.5
    table_d = rel_bias[:, NSA_HEADS:]
    bidx = jnp.arange(B)[:, None, None]
    s_pos = jnp.arange(S)

    def block(args):
        i, qb, qib, wib = args
        t = i * Q_BLOCK + jnp.arange(Q_BLOCK)
        idx_logits = jnp.einsum('bthe,bse->bths', qib, ki)
        score = jnp.einsum('bths,bth->bts', jax.nn.relu(idx_logits), wib).astype(jnp.float32)
        score = jnp.where(s_pos[None, None, :] <= t[None, :, None], score, NEG_INF)
        _, idx = lax.top_k(score, k_top)
        c_g = ckv[bidx, idx]
        q_lat = jnp.einsum('bthd,chd->bthc', qb, w_uk)
        dist = t[None, :, None] - idx
        bias = jnp.moveaxis(table_d[_t5_bucket(dist)], -1, 2)
        s = jnp.einsum('bthc,btkc->bthk', q_lat, c_g).astype(jnp.float32) * scale + bias
        p = _masked_softmax(s, (dist >= 0)[:, :, None, :])
        o_lat = jnp.einsum('bthk,btkc->bthc', p.astype(c_g.dtype), c_g)
        o = jnp.einsum('bthc,chd->bthd', o_lat, w_uv)
        return o.reshape(B, Q_BLOCK, DSA_HEADS * DSA_HEAD_DIM)

    nq = S // Q_BLOCK
    out = lax.map(block, (jnp.arange(nq), _to_blocks(q), _to_blocks(qi), _to_blocks(wi)))
    return _from_blocks(out)


def _mixer(h, w_in, pe_k, pe_v, wk1, wk2, wv1, wv2, g_kv, w_uk, w_uv,
           w_up_nsa, w_up_dsa, w_out, rel_bias):
    B, S, D = h.shape
    cuts = [int(v) for v in np.cumsum(IN_SPLITS)[:-1]]
    (q_n, kc, vc, ks, vs, kw, vw, g_n, q_d, ckv, qi, ki, wi, a_m) = jnp.split(h @ w_in, cuts, axis=-1)
    kv_shape = (B, S, NSA_KV_GROUPS, NSA_HEAD_DIM)
    o_n = _nsa(q_n.reshape(B, S, NSA_HEADS, NSA_HEAD_DIM),
               kc.reshape(kv_shape), vc.reshape(kv_shape),
               ks.reshape(kv_shape), vs.reshape(kv_shape),
               kw.reshape(kv_shape), vw.reshape(kv_shape),
               jax.nn.sigmoid(g_n).reshape(B, S, NSA_HEADS, 3),
               pe_k, pe_v, wk1, wk2, wv1, wv2, rel_bias)
    o_d = _dsa(q_d.reshape(B, S, DSA_HEADS, DSA_HEAD_DIM),
               _rmsnorm(ckv, g_kv),
               qi.reshape(B, S, IDX_HEADS, IDX_DIM), ki, wi * INDEX_SCALE,
               w_uk, w_uv, rel_bias)
    a_m = jax.nn.sigmoid(a_m).reshape(B, S, 2, D)
    y = a_m[:, :, 0] * (o_n @ w_up_nsa) + a_m[:, :, 1] * (o_d @ w_up_dsa)
    return y @ w_out


def setup_inputs(seed: int = 0) -> dict:
    key = jax.random.key(seed)
    k = jax.random.split(key, 24)
    f32 = jnp.float32
    D = D_MODEL

    def nrm(kk, shape, s):
        return jax.random.normal(kk, shape, f32) * s

    cmp_in = NSA_CMP_LEN * NSA_HEAD_DIM
    return {
        "x": nrm(k[0], (BATCH, SEQ, D), 1.0),
        "c": nrm(k[1], (BATCH, D), 1.0),
        "w_ada": nrm(k[2], (DEPTH, D, N_SUBLAYERS * 3 * D), ADA_INIT * D ** -0.5),
        "b_ada": nrm(k[3], (DEPTH, N_SUBLAYERS * 3 * D), 0.02),
        "g_norm": 1.0 + nrm(k[4], (DEPTH, N_SUBLAYERS, D), 0.02),
        "w_ffn_in": nrm(k[5], (DEPTH, 2, D, 2 * D_FF), D ** -0.5),
        "w_ffn_out": nrm(k[6], (DEPTH, 2, D_FF, D), D_FF ** -0.5),
        "w_in": nrm(k[7], (DEPTH, D, N_IN), D ** -0.5),
        "nsa_pe_k": nrm(k[8], (DEPTH, NSA_CMP_LEN, NSA_HEAD_DIM), 0.5),
        "nsa_pe_v": nrm(k[9], (DEPTH, NSA_CMP_LEN, NSA_HEAD_DIM), 0.5),
        "nsa_cmp_k1": nrm(k[10], (DEPTH, cmp_in, NSA_CMP_HIDDEN), cmp_in ** -0.5),
        "nsa_cmp_k2": nrm(k[11], (DEPTH, NSA_CMP_HIDDEN, NSA_HEAD_DIM), NSA_CMP_HIDDEN ** -0.5),
        "nsa_cmp_v1": nrm(k[12], (DEPTH, cmp_in, NSA_CMP_HIDDEN), cmp_in ** -0.5),
        "nsa_cmp_v2": nrm(k[13], (DEPTH, NSA_CMP_HIDDEN, NSA_HEAD_DIM), NSA_CMP_HIDDEN ** -0.5),
        "dsa_g_kv": 1.0 + nrm(k[14], (DEPTH, DSA_KV_LATENT), 0.02),
        "dsa_w_uk": nrm(k[15], (DEPTH, DSA_KV_LATENT, DSA_HEADS, DSA_HEAD_DIM), DSA_KV_LATENT ** -0.5),
        "dsa_w_uv": nrm(k[16], (DEPTH, DSA_KV_LATENT, DSA_HEADS, DSA_HEAD_DIM), DSA_KV_LATENT ** -0.5),
        "w_up_nsa": nrm(k[17], (DEPTH, NSA_HEADS * NSA_HEAD_DIM, D), (NSA_HEADS * NSA_HEAD_DIM) ** -0.5),
        "w_up_dsa": nrm(k[18], (DEPTH, DSA_HEADS * DSA_HEAD_DIM, D), (DSA_HEADS * DSA_HEAD_DIM) ** -0.5),
        "w_out": nrm(k[19], (DEPTH, D, D), D ** -0.5),
        "rel_bias": nrm(k[20], (REL_BUCKETS, TOTAL_HEADS), 0.5),
        "g_final": 1.0 + nrm(k[21], (D,), 0.02),
    }


def reference(x, c, w_ada, b_ada, g_norm, w_ffn_in, w_ffn_out, w_in,
              nsa_pe_k, nsa_pe_v, nsa_cmp_k1, nsa_cmp_k2, nsa_cmp_v1, nsa_cmp_v2,
              dsa_g_kv, dsa_w_uk, dsa_w_uv, w_up_nsa, w_up_dsa, w_out, rel_bias, g_final):
    B = x.shape[0]
    c_act = jax.nn.silu(c)
    for l in range(DEPTH):
        mod = (c_act @ w_ada[l] + b_ada[l]).reshape(B, N_SUBLAYERS, 3, D_MODEL)
        h = _modulate(x, g_norm[l, 0], mod[:, 0])
        x = x + 0.5 * mod[:, 0, 2][:, None, :] * _swiglu(h, w_ffn_in[l, 0], w_ffn_out[l, 0])
        h = _modulate(x, g_norm[l, 1], mod[:, 1])
        y = _mixer(h, w_in[l], nsa_pe_k[l], nsa_pe_v[l], nsa_cmp_k1[l], nsa_cmp_k2[l],
                   nsa_cmp_v1[l], nsa_cmp_v2[l], dsa_g_kv[l], dsa_w_uk[l], dsa_w_uv[l],
                   w_up_nsa[l], w_up_dsa[l], w_out[l], rel_bias)
        x = x + mod[:, 1, 2][:, None, :] * y
        h = _modulate(x, g_norm[l, 2], mod[:, 2])
        x = x + 0.5 * mod[:, 2, 2][:, None, :] * _swiglu(h, w_ffn_in[l, 1], w_ffn_out[l, 1])
    return _rmsnorm(x, g_final)
```

```cpp
#include <hip/hip_runtime.h>
#include <cstdio>
#include <cstdint>


#ifndef PHM
#define PHM 0xffff
#endif
#define PHON(k) (((PHM) >> (k)) & 1)
#ifndef REP_P0
#define REP_P0 1
#endif
#ifndef REP_FFI
#define REP_FFI 1
#endif
#ifndef REP_FFO
#define REP_FFO 1
#endif
#ifndef REP_WIN
#define REP_WIN 1
#endif
#ifndef REP_UP
#define REP_UP 1
#endif
#ifndef REP_MOD
#define REP_MOD 1
#endif
#ifndef REP_THIN
#define REP_THIN 1
#endif
#ifndef REP_ALL
#define REP_ALL 1
#endif
#ifndef REP_NSA
#define REP_NSA 1
#endif
#ifndef REP_DSA
#define REP_DSA 1
#endif

__device__ __forceinline__ int fresh_lane() { unsigned z = 0u; asm volatile("" : "+v"(z)); return (int)__builtin_amdgcn_mbcnt_hi(~0u, __builtin_amdgcn_mbcnt_lo(~0u, z)); }

namespace pg8 {
#define PG8_LAS __attribute__((address_space(3)))
typedef unsigned short bf16_t;
typedef short bf16x8 __attribute__((ext_vector_type(8)));
typedef float f32x4 __attribute__((ext_vector_type(4)));
typedef float f32x2 __attribute__((ext_vector_type(2)));
typedef unsigned u32x4 __attribute__((ext_vector_type(4)));
typedef unsigned u32x2 __attribute__((ext_vector_type(2)));
constexpr int BM = 256, BK = 64, HALF = 128, HTB = HALF * BK * 2, STAGE_BYTES = 8 * HTB, NXCD = 8, WGM = 8;

__host__ __device__ __forceinline__ int lds_byte(int r, int c) { const int st = (r >> 4) * 2 + (c >> 5), rr = r & 15, cc = c & 31, ob = rr * 64 + cc * 2; return st * 1024 + (ob ^ (((ob >> 9) & 1) << 5)); }
__host__ __device__ __forceinline__ void stage_rc(int b, int& R, int& C) { const int st = b / 1024, sb = b % 1024, swz = sb ^ (((sb >> 9) & 1) << 5); R = (st >> 1) * 16 + swz / 64; C = (st & 1) * 32 + (swz % 64) / 2; }
__host__ __device__ __forceinline__ int perm32(int rho) { const int n = rho >> 4, i = rho & 15; return 8 * (i >> 2) + 4 * n + (i & 3); }

struct Unit { int pm, pn; };
struct Gemm { const bf16_t* A; const bf16_t* Bt; int M, N, K, lda, ldb; };

struct StaticOrder {
    int nM, nN, nwg, G, c;
    __host__ __device__ void init(int M, int N, int G_, int c_) { nM = M / BM; nN = N / BM; nwg = nM * nN; G = G_; c = c_; }
    __host__ __device__ bool next(int i, Unit& u) const {
        const long L = (long)i * G + c; if (L >= nwg) return false;
        int wgid = (int)L; { const int q = nwg / NXCD, r = nwg % NXCD, xcd = wgid % NXCD, off = wgid / NXCD; wgid = (xcd < r ? xcd * (q + 1) : r * (q + 1) + (xcd - r) * q) + off; }
        const int nig = WGM * nN, gid = wgid / nig, fm = gid * WGM, gsz = (nM - fm) < WGM ? (nM - fm) : WGM;
        u.pm = fm + ((wgid % nig) % gsz); u.pn = (wgid % nig) / gsz; return true;
    }
    __device__ __forceinline__ void a_ready(const Unit&) const {}
    __device__ __forceinline__ void done(const Unit&) const {}
};

typedef __bf16 pk_bf2_t __attribute__((ext_vector_type(2)));
typedef float pk_f2_t __attribute__((ext_vector_type(2)));
__device__ __forceinline__ unsigned cvt_pk_bf16(float lo, float hi) { const pk_f2_t v = {lo, hi}; return __builtin_bit_cast(unsigned, __builtin_convertvector(v, pk_bf2_t)); }

template <class Epi, class Sched, bool ALIGN_EPI = false, bool SP2 = false>
__device__ __forceinline__ void gemm_phase(PG8_LAS unsigned char* lds, const Gemm g, const Sched& S, const Epi& E, int wave_s) {
    int tid_ = (wave_s << 6) | fresh_lane(); asm volatile("" : "+v"(tid_));
    const int tid = tid_, wid = __builtin_amdgcn_readfirstlane(tid >> 6), lane = tid & 63, wr = wid >> 2, wc = wid & 3, fr = lane & 15, fq = lane >> 4;
    const int K = g.K, nt = K / BK;
    unsigned voffA[2], voffB[2];
#pragma unroll
    for (int i = 0; i < 2; ++i) { int R, C; stage_rc(tid * 16 + i * 8192, R, C); const int Rb = Epi::PERM ? ((R & ~31) + perm32(R & 31)) : R;
        voffA[i] = (unsigned)(R * g.lda + C) * 2u; voffB[i] = (unsigned)(Rb * g.ldb + C) * 2u; }
    const size_t kstep = (size_t)(BK * 2);
    const size_t hstepA = (size_t)HALF * g.lda * 2, hstepB = (size_t)HALF * g.ldb * 2;
    const size_t tstepA = 2 * hstepA, tstepB = 2 * hstepB;
    const unsigned ldsw = (unsigned)wid * 1024u;
    const int aoff = lds_byte(wr * 64 + fr, fq * 8), boff = lds_byte(wc * 32 + fr, fq * 8);
#define PG8_SA(b, h) (((b) * 2 + (h)) * HTB)
#define PG8_SB(b, h) ((4 + (b) * 2 + (h)) * HTB)
#define PG8_STAGE(bufoff, gbase, voff) do { _Pragma("unroll") for (int _i = 0; _i < 2; ++_i) \
        __builtin_amdgcn_global_load_lds((const unsigned*)((const char*)(gbase) + (voff)[_i]), (PG8_LAS unsigned*)(lds + (bufoff) + ldsw + _i * 8192), 16, 0, 0); } while (0)
#define PG8_LDA(dst, b, h) do { _Pragma("unroll") for (int m = 0; m < 4; ++m) _Pragma("unroll") for (int k = 0; k < 2; ++k) dst[m][k] = *(const PG8_LAS bf16x8*)(lds + PG8_SA(b, h) + aoff + m * 2048 + k * 1024); } while (0)
#define PG8_LDB(dst, b, h) do { _Pragma("unroll") for (int n = 0; n < 2; ++n) _Pragma("unroll") for (int k = 0; k < 2; ++k) dst[n][k] = *(const PG8_LAS bf16x8*)(lds + PG8_SB(b, h) + boff + n * 2048 + k * 1024); } while (0)
#define PG8_MMA(ai, bj, At, Bt) do { __builtin_amdgcn_s_setprio(1); _Pragma("unroll") for (int m = 0; m < 4; ++m) _Pragma("unroll") for (int n = 0; n < 2; ++n) _Pragma("unroll") for (int k = 0; k < 2; ++k) \
        acc[ai][bj][m][n] = __builtin_amdgcn_mfma_f32_16x16x32_bf16(Bt[n][k], At[m][k], acc[ai][bj][m][n], 0, 0, 0); __builtin_amdgcn_s_setprio(0); } while (0)
#define PG8_WAIT_V(n) asm volatile("s_waitcnt vmcnt(" #n ")" ::: "memory")
#define PG8_WAIT_L(n) asm volatile("s_waitcnt lgkmcnt(" #n ")" ::: "memory")
#define PG8_BAR __builtin_amdgcn_s_barrier()
#define PG8_SCHED __builtin_amdgcn_sched_barrier(0)
    Unit cur, nxt; int ui = 0;
    if (!S.next(0, cur)) return;
    f32x4 acc[2][2][4][2];
#pragma unroll
    for (int a = 0; a < 2; ++a)
#pragma unroll
        for (int b = 0; b < 2; ++b)
#pragma unroll
            for (int m = 0; m < 4; ++m)
#pragma unroll
                for (int n = 0; n < 2; ++n) acc[a][b][m][n] = (f32x4){0.f, 0.f, 0.f, 0.f};
    bf16x8 At[4][2], B0[2][2], B1[2][2];
    const char* cA = (const char*)g.A + (size_t)cur.pm * tstepA; const char* cB = (const char*)g.Bt + (size_t)cur.pn * tstepB;
    S.a_ready(cur);
    if constexpr (SP2) {
        PG8_STAGE(PG8_SB(0, 0), cB, voffB); PG8_STAGE(PG8_SB(0, 1), cB + hstepB, voffB); PG8_STAGE(PG8_SA(0, 0), cA, voffA); PG8_STAGE(PG8_SA(0, 1), cA + hstepA, voffA);
        if (wr == 1) PG8_BAR;
        PG8_WAIT_V(2); PG8_BAR;
        PG8_STAGE(PG8_SB(1, 0), cB + kstep, voffB); PG8_STAGE(PG8_SA(1, 0), cA + kstep, voffA); PG8_STAGE(PG8_SB(1, 1), cB + hstepB + kstep, voffB);
        PG8_WAIT_V(6); PG8_BAR;
    } else {
        PG8_STAGE(PG8_SB(0, 0), cB, voffB); PG8_STAGE(PG8_SA(0, 0), cA, voffA); PG8_STAGE(PG8_SB(0, 1), cB + hstepB, voffB); PG8_STAGE(PG8_SA(0, 1), cA + hstepA, voffA);
        if (wr == 1) PG8_BAR;
        PG8_WAIT_V(4); PG8_BAR;
        PG8_STAGE(PG8_SB(1, 0), cB + kstep, voffB); PG8_STAGE(PG8_SA(1, 0), cA + kstep, voffA); PG8_STAGE(PG8_SB(1, 1), cB + hstepB + kstep, voffB);
        PG8_WAIT_V(6); PG8_BAR;
    }
    for (;;) {
        const bool has_next = S.next(ui + 1, nxt);
        const char* nA = has_next ? (const char*)g.A + (size_t)nxt.pm * tstepA : cA; const char* nB = has_next ? (const char*)g.Bt + (size_t)nxt.pn * tstepB : cB;
        for (int t = 0; t < nt; t += 2) {
            const bool last = (t == nt - 2);
            const char* a1 = cA + (size_t)(t + 1) * kstep;
            const char* a2 = last ? nA : cA + (size_t)(t + 2) * kstep; const char* b2 = last ? nB : cB + (size_t)(t + 2) * kstep;
            const char* a3 = a2 + kstep; const char* b3 = b2 + kstep;
            if (last && has_next) S.a_ready(nxt);
            if constexpr (Epi::HAS_MID) { if (t == nt / 2) E.mid(acc, cur, wr, wc, fr, fq); }
            if constexpr (SP2) {
            PG8_LDB(B0, 0, 0); PG8_LDB(B1, 0, 1); PG8_SCHED; PG8_LDA(At, 0, 0); PG8_STAGE(PG8_SA(1, 1), a1 + hstepA, voffA);
            PG8_WAIT_V(8); PG8_WAIT_L(0); PG8_BAR; PG8_MMA(0, 0, At, B0); PG8_MMA(0, 1, At, B1); PG8_BAR; PG8_SCHED;
            PG8_LDA(At, 0, 1); PG8_STAGE(PG8_SB(0, 0), b2, voffB); PG8_STAGE(PG8_SB(0, 1), b2 + hstepB, voffB); PG8_STAGE(PG8_SA(0, 0), a2, voffA);
            PG8_WAIT_V(8); PG8_WAIT_L(0); PG8_BAR; PG8_MMA(1, 0, At, B0); PG8_MMA(1, 1, At, B1); PG8_BAR; PG8_SCHED;
            PG8_LDB(B0, 1, 0); PG8_LDB(B1, 1, 1); PG8_SCHED; PG8_LDA(At, 1, 0); PG8_STAGE(PG8_SA(0, 1), a2 + hstepA, voffA);
            PG8_WAIT_V(8); PG8_WAIT_L(0); PG8_BAR; PG8_MMA(0, 0, At, B0); PG8_MMA(0, 1, At, B1); PG8_BAR; PG8_SCHED;
            PG8_LDA(At, 1, 1); PG8_STAGE(PG8_SB(1, 0), b3, voffB); PG8_STAGE(PG8_SB(1, 1), b3 + hstepB, voffB); PG8_STAGE(PG8_SA(1, 0), a3, voffA);
            PG8_WAIT_V(8); PG8_WAIT_L(0); PG8_BAR; PG8_MMA(1, 0, At, B0); PG8_MMA(1, 1, At, B1); PG8_BAR; PG8_SCHED;
            } else {
            PG8_LDB(B0, 0, 0); PG8_SCHED; PG8_LDA(At, 0, 0); PG8_STAGE(PG8_SA(1, 1), a1 + hstepA, voffA);
            PG8_WAIT_L(8); PG8_BAR; PG8_WAIT_L(0); PG8_MMA(0, 0, At, B0); PG8_BAR; PG8_SCHED;
            PG8_LDB(B1, 0, 1); PG8_STAGE(PG8_SB(0, 0), b2, voffB);
            PG8_BAR; PG8_WAIT_L(0); PG8_MMA(0, 1, At, B1); PG8_BAR;
            PG8_LDA(At, 0, 1); PG8_STAGE(PG8_SA(0, 0), a2, voffA);
            PG8_BAR; PG8_WAIT_L(0); PG8_MMA(1, 0, At, B0); PG8_BAR; PG8_SCHED;
            PG8_STAGE(PG8_SB(0, 1), b2 + hstepB, voffB);
            PG8_WAIT_V(6); PG8_BAR; PG8_MMA(1, 1, At, B1); PG8_BAR;
            PG8_LDB(B0, 1, 0); PG8_SCHED; PG8_LDA(At, 1, 0); PG8_STAGE(PG8_SA(0, 1), a2 + hstepA, voffA);
            PG8_WAIT_L(8); PG8_BAR; PG8_WAIT_L(0); PG8_MMA(0, 0, At, B0); PG8_BAR; PG8_SCHED;
            PG8_LDB(B1, 1, 1); PG8_STAGE(PG8_SB(1, 0), b3, voffB);
            PG8_BAR; PG8_WAIT_L(0); PG8_MMA(0, 1, At, B1); PG8_BAR;
            PG8_LDA(At, 1, 1); PG8_STAGE(PG8_SA(1, 0), a3, voffA);
            PG8_BAR; PG8_WAIT_L(0); PG8_MMA(1, 0, At, B0); PG8_BAR; PG8_SCHED;
            PG8_STAGE(PG8_SB(1, 1), b3 + hstepB, voffB);
            PG8_WAIT_V(6); PG8_BAR; PG8_MMA(1, 1, At, B1); PG8_BAR;
            }
        }
        if constexpr (ALIGN_EPI) { if (wr == 0) PG8_BAR; }
        E(acc, cur, wr, wc, fr, fq); S.done(cur);
        if (!has_next) break;
#pragma unroll
        for (int a = 0; a < 2; ++a)
#pragma unroll
            for (int b = 0; b < 2; ++b)
#pragma unroll
                for (int m = 0; m < 4; ++m)
#pragma unroll
                    for (int n = 0; n < 2; ++n) acc[a][b][m][n] = (f32x4){0.f, 0.f, 0.f, 0.f};
        cur = nxt; cA = nA; cB = nB; ++ui;
        if constexpr (ALIGN_EPI) { if (wr == 1) PG8_BAR; }
    }
    PG8_WAIT_V(0);
    if constexpr (!ALIGN_EPI) { if (wr == 0) PG8_BAR; }
    PG8_BAR;
#undef PG8_SA
#undef PG8_SB
#undef PG8_STAGE
#undef PG8_LDA
#undef PG8_LDB
#undef PG8_MMA
#undef PG8_WAIT_V
#undef PG8_WAIT_L
#undef PG8_BAR
#undef PG8_SCHED
}
}

constexpr int NB = 4, SEQ = 4096, M = NB * SEQ, D = 2048, FF = 5632, NIN = 8544, NINP = 8704, DEPTH = 2, NMOD = 9 * D;
constexpr int NWAVES = 8;
constexpr float RMS_EPS = 1e-6f;
constexpr int NPL = 14;
constexpr int NPH = 1 + DEPTH * NPL + 1;

constexpr size_t MiB = 1u << 20;
constexpr size_t al4k(size_t x) { return (x + 4095) & ~(size_t)4095; }
constexpr size_t WS_CTL = 0, CTL_ZERO_BYTES = 1 * MiB;
constexpr size_t WS_MOD = 1 * MiB;
constexpr size_t WS_WFI = WS_MOD + al4k((size_t)DEPTH * NB * NMOD * 4);
constexpr size_t SZ_WFI1 = (size_t)2 * FF * D * 2;
constexpr size_t WS_WFO = WS_WFI + 4 * SZ_WFI1;
constexpr size_t SZ_WFO1 = (size_t)D * FF * 2;
constexpr size_t WS_WIN = WS_WFO + 4 * SZ_WFO1;
constexpr size_t SZ_WIN1 = (size_t)NINP * D * 2;
constexpr size_t WS_WUPN = WS_WIN + 2 * SZ_WIN1;
constexpr size_t SZ_WUP1 = (size_t)D * 1024 * 2;
constexpr size_t WS_WUPD = WS_WUPN + 2 * SZ_WUP1;
constexpr size_t WS_WOUT = WS_WUPD + 2 * SZ_WUP1;
constexpr size_t SZ_WOUT1 = (size_t)D * D * 2;
constexpr size_t WS_X = WS_WOUT + 2 * SZ_WOUT1;
constexpr size_t WS_H = WS_X + (size_t)M * D * 4;
constexpr size_t WS_ACT = WS_H + (size_t)M * D * 2;
constexpr size_t SZ_QN = (size_t)M * 1024 * 2, SZ_KV1 = (size_t)M * 256 * 2;
constexpr size_t WS_QN = WS_ACT + (size_t)M * FF * 2;
constexpr size_t WS_KV = WS_QN + SZ_QN;
constexpr size_t WS_QD = WS_KV + 6 * SZ_KV1 + 65536;
constexpr size_t WS_CKVR = WS_QD + SZ_QN;
constexpr size_t WS_CKVN = WS_CKVR + (size_t)M * 256 * 4;
constexpr size_t WS_QI = WS_CKVN + (size_t)M * 256 * 2;
constexpr size_t WS_KI = WS_QI + (size_t)M * 512 * 2;
constexpr size_t WS_WI = WS_KI + (size_t)M * 32 * 2;
constexpr size_t WS_GN = WS_WI + (size_t)M * 16 * 4;
constexpr size_t WS_AM = WS_GN + (size_t)M * 48 * 4;
constexpr size_t WS_QLAT = WS_AM + (size_t)M * 4096 * 2;
constexpr size_t WS_OLAT = WS_QLAT + (size_t)M * 4096 * 2;
constexpr size_t WS_CMPH = WS_OLAT + (size_t)M * 4096 * 2;
constexpr size_t WS_KCMP = WS_CMPH + (size_t)2 * 4096 * 256 * 2;
constexpr size_t WS_ON = WS_KCMP + (size_t)2 * 16 * 256 * 64 * 2;
constexpr size_t WS_OD = WS_ON + SZ_QN;
constexpr size_t WS_WC1 = WS_OD + SZ_QN;
constexpr size_t WS_WC2 = WS_WC1 + (size_t)DEPTH * 512 * 2048 * 2;
constexpr size_t WS_B1 = WS_WC2 + (size_t)DEPTH * 2 * 64 * 256 * 2;
constexpr size_t WS_WUK = WS_B1 + 4096;
constexpr size_t WS_WUVT = WS_WUK + (size_t)DEPTH * 256 * 1024 * 2;
constexpr size_t WS_END = WS_WUVT + (size_t)DEPTH * 1024 * 256 * 2;
constexpr size_t WS_YT = WS_ACT;
constexpr size_t WS_Y = WS_H;
constexpr float QSCALE = 0.125f * 1.4426950408889634f, LOG2E = 1.4426950408889634f, INDEX_SCALE = 0.04419417382415922f;

constexpr int CW_TMO = 0, CW_CODE = 1;
constexpr int CW_BAR = 4096;

constexpr int RING_OFF = 0, RING_BYTES = 131072;
constexpr int LDSCTL_OFF = RING_BYTES, MISC_OFF = LDSCTL_OFF + 320;
constexpr int EXTRA_OFF = 132096;
constexpr int LDS_BYTES = 163840;

#define GAS __attribute__((address_space(1)))
#define LAS __attribute__((address_space(3)))
typedef unsigned short bf16;
typedef unsigned v4u __attribute__((ext_vector_type(4)));
typedef float f32x4 __attribute__((ext_vector_type(4)));
typedef short bf16x8 __attribute__((ext_vector_type(8)));
typedef GAS unsigned gu32;
#define RLX_AGENT __ATOMIC_RELAXED, __HIP_MEMORY_SCOPE_AGENT
#define LDS_WAIT() asm volatile("s_waitcnt lgkmcnt(0)" ::: "memory")
#define VM_WAIT() asm volatile("s_waitcnt vmcnt(0)" ::: "memory")
__device__ __forceinline__ unsigned f2bf(float f) { unsigned u = __builtin_bit_cast(unsigned, f); return (u + 0x7fffu + ((u >> 16) & 1u)) >> 16; }
__device__ __forceinline__ unsigned pk2(float lo, float hi) { return pg8::cvt_pk_bf16(lo, hi); }
typedef __bf16 hbf2 __attribute__((ext_vector_type(2)));
typedef float hf2 __attribute__((ext_vector_type(2)));
__device__ __forceinline__ unsigned cvtpk(float lo, float hi) { const hf2 v = {lo, hi}; return __builtin_bit_cast(unsigned, __builtin_convertvector(v, hbf2)); }
template <class T> __device__ __forceinline__ T* launder(T* p) { asm volatile("" : "+s"(p)); return p; }

#define XB_TMO      128
#define XB_XCNT(j)  (256  + 64 * (j))
#define XB_XSUB(j)  (1280 + 64 * (j))
#define XB_XGEN(j)  (2304 + 64 * (j))
#define XB_TOP      3328
#define XB_TOPGEN   3392
#define XCD_BAR_WORDS 3456
#define XB_SPIN_CAP (1u << 25)

__device__ __forceinline__ unsigned xb_ld(unsigned* p)              { return __hip_atomic_load(p, __ATOMIC_RELAXED, __HIP_MEMORY_SCOPE_AGENT); }
__device__ __forceinline__ unsigned xb_add(unsigned* p, unsigned v) { return __hip_atomic_fetch_add(p, v, __ATOMIC_RELAXED, __HIP_MEMORY_SCOPE_AGENT); }
__device__ __forceinline__ unsigned xb_xcc_id() { return (unsigned)__builtin_amdgcn_s_getreg((3 << 11) | 20) & 0xFu; }
#define XB_SPIN(cond, bar) do { unsigned _sp = 0; while (cond) { __builtin_amdgcn_s_sleep(1); \
    if ((++_sp & 255u) == 0u) { if (xb_ld(&(bar)[XB_TMO])) break; if (_sp > XB_SPIN_CAP) { atomicAdd(&(bar)[XB_TMO], 1u); break; } } } } while (0)

struct XcdBarrier { unsigned* bar; unsigned x; volatile LAS unsigned* st; };

__device__ __forceinline__ XcdBarrier xcd_barrier_post(unsigned* bar, volatile LAS unsigned* st) {
    XcdBarrier b; b.bar = bar; b.x = xb_xcc_id(); b.st = st;
    if (threadIdx.x == 0) (void)xb_add(&bar[XB_XCNT(b.x)], 1u);
    return b;
}
__device__ __forceinline__ void xcd_barrier_complete(unsigned* bar, unsigned x, unsigned& nloc, unsigned& nx) {
    const unsigned G = gridDim.x * gridDim.y * gridDim.z;
    unsigned sum, cnt, mine, sp = 0u;
    for (;;) {
        sum = 0u; cnt = 0u; mine = 0u;
#pragma unroll
        for (unsigned j = 0; j < 16; ++j) { const unsigned c = xb_ld(&bar[XB_XCNT(j)]); sum += c; cnt += (c > 0u) ? 1u : 0u; mine = (j == x) ? c : mine; }
        if (sum == G) break;
        __builtin_amdgcn_s_sleep(1);
        if ((++sp & 255u) == 0u) { if (xb_ld(&bar[XB_TMO])) break; if (sp > XB_SPIN_CAP) { atomicAdd(&bar[XB_TMO], 1u); break; } }
    }
    nloc = mine > 0u ? mine : 1u; nx = cnt > 0u ? cnt : 1u;
}
__device__ __forceinline__ void xcd_barrier(const XcdBarrier& b, int wave_s) {
    asm volatile("s_waitcnt vmcnt(0)" ::: "memory");
    __syncthreads();
    if (wave_s == 0 && fresh_lane() == 0) {
        unsigned* bar = b.bar; asm volatile("" : "+s"(bar));
        __builtin_amdgcn_s_waitcnt(0);
        unsigned nloc = b.st[0], nx = b.st[1];
        if (nloc == 0u) { xcd_barrier_complete(bar, b.x, nloc, nx); b.st[0] = nloc; b.st[1] = nx; }
        const unsigned old = xb_add(&bar[XB_XSUB(b.x)], 1u);
        const unsigned gen = old / nloc;
        if (old + 1u == (gen + 1u) * nloc) {
            __builtin_amdgcn_fence(__ATOMIC_RELEASE, "agent");
            asm volatile("s_waitcnt vmcnt(0)" ::: "memory");
            const unsigned og = xb_add(&bar[XB_TOP], 1u);
            const unsigned tg = og / nx;
            if (og + 1u == (tg + 1u) * nx) xb_add(&bar[XB_TOPGEN], 1u);
            else XB_SPIN(xb_ld(&bar[XB_TOPGEN]) == tg, bar);
            __builtin_amdgcn_fence(__ATOMIC_ACQUIRE, "agent");
            xb_add(&bar[XB_XGEN(b.x)], 1u);
            asm volatile("s_waitcnt vmcnt(0)" ::: "memory");
        } else {
            XB_SPIN(xb_ld(&bar[XB_XGEN(b.x)]) == gen, bar);
            __builtin_amdgcn_fence(__ATOMIC_ACQUIRE, "agent");
            asm volatile("s_waitcnt vmcnt(0)" ::: "memory");
        }
    }
    __syncthreads();
}

struct Frame {
    LAS unsigned char* lds;
    volatile LAS unsigned* MISC;
    gu32* ctl;
    int tid, lane, wave;
    int vcu, G;
};

__device__ __forceinline__ Frame refresh(const Frame& F0) { Frame F = F0; int t = (F0.wave << 6) | fresh_lane(); asm volatile("" : "+v"(t)); F.tid = t; F.lane = t & 63; F.wave = __builtin_amdgcn_readfirstlane(t >> 6); return F; }
template <int X> __device__ __forceinline__ float swz(float v) { return __builtin_bit_cast(float, __builtin_amdgcn_ds_swizzle(__builtin_bit_cast(int, v), (X << 10) | 0x1f)); }
struct SwapPair { unsigned a, b; };
__device__ __forceinline__ SwapPair swap32(float v) { unsigned a = __builtin_bit_cast(unsigned, v), b = a; asm volatile("" : "+v"(b)); auto r = __builtin_amdgcn_permlane32_swap(a, b, false, false); return SwapPair{r[0], r[1]}; }
__device__ __forceinline__ SwapPair swap32p(float x, float y) { unsigned a = __builtin_bit_cast(unsigned, x), b = __builtin_bit_cast(unsigned, y); asm volatile("" : "+v"(a), "+v"(b)); auto r = __builtin_amdgcn_permlane32_swap(a, b, false, false); return SwapPair{r[0], r[1]}; }
__device__ __forceinline__ SwapPair swap16p(float x, float y) { unsigned a = __builtin_bit_cast(unsigned, x), b = __builtin_bit_cast(unsigned, y); asm volatile("" : "+v"(a), "+v"(b)); auto r = __builtin_amdgcn_permlane16_swap(a, b, false, false); return SwapPair{r[0], r[1]}; }
__device__ __forceinline__ float xsum32(float v) { const SwapPair r = swap32(v); return __builtin_bit_cast(float, r.a) + __builtin_bit_cast(float, r.b); }
__device__ __forceinline__ float xmax32(float v) { const SwapPair r = swap32(v); return fmaxf(__builtin_bit_cast(float, r.a), __builtin_bit_cast(float, r.b)); }
__device__ __forceinline__ float xget32(float v, bool upper) { const SwapPair r = swap32(v); return __builtin_bit_cast(float, upper ? r.a : r.b); }
__device__ __forceinline__ SwapPair swap16(float v) { unsigned a = __builtin_bit_cast(unsigned, v), b = a; asm volatile("" : "+v"(b)); auto r = __builtin_amdgcn_permlane16_swap(a, b, false, false); return SwapPair{r[0], r[1]}; }
__device__ __forceinline__ float xsum16(float v) { const SwapPair r = swap16(v); return __builtin_bit_cast(float, r.a) + __builtin_bit_cast(float, r.b); }
__device__ __forceinline__ float xmax16(float v) { const SwapPair r = swap16(v); return fmaxf(__builtin_bit_cast(float, r.a), __builtin_bit_cast(float, r.b)); }
__device__ __forceinline__ float xget16(float v, bool oddrow) { const SwapPair r = swap16(v); return __builtin_bit_cast(float, oddrow ? r.a : r.b); }
__device__ __forceinline__ int wave_total_i(int v) {
    v += __builtin_amdgcn_update_dpp(0, v, 0xB1, 0xf, 0xf, true);
    v += __builtin_amdgcn_update_dpp(0, v, 0x4E, 0xf, 0xf, true);
    v += __builtin_amdgcn_update_dpp(0, v, 0x141, 0xf, 0xf, true);
    v += __builtin_amdgcn_update_dpp(0, v, 0x140, 0xf, 0xf, true);
    return (__builtin_amdgcn_readlane(v, 0) + __builtin_amdgcn_readlane(v, 16)) + (__builtin_amdgcn_readlane(v, 32) + __builtin_amdgcn_readlane(v, 48));
}
__device__ __forceinline__ float wave_sum(float v) {
    v += swz<1>(v); v += swz<2>(v); v += swz<4>(v); v += swz<8>(v); v += swz<16>(v);
    return xsum32(v);
}
__device__ __forceinline__ float silu_f(float g) { return g * __builtin_amdgcn_rcpf(1.0f + __builtin_amdgcn_exp2f(-1.4426950408889634f * g)); }
__device__ __forceinline__ float sigmoid_f(float g) { return __builtin_amdgcn_rcpf(1.0f + __builtin_amdgcn_exp2f(-1.4426950408889634f * g)); }

struct MapIdent { __device__ __forceinline__ int operator()(int n) const { return n; } };
struct MapFfnIn {
    __device__ __forceinline__ int operator()(int n) const { const int isu = n >= FF, c = isu ? n - FF : n; return (c >> 7) * 256 + isu * 128 + (c & 127); } };
struct MapWin {
    __device__ __forceinline__ int operator()(int n) const { return n < 2560 ? n : (n < 2608 ? n + 1840 : (n < 4448 ? n - 48 : n + 160)); } };
template <class Map>
__device__ __forceinline__ void p0_transpose_item(const float* W, int K, int N, bf16* WT, const Map& mp, LAS float* scr, int item, int lane, int ldk = 0, int koff = 0) {
    if (ldk == 0) ldk = K;
    const int nblk = N / 32, kb = item / nblk, nb = item % nblk, k0 = 64 * kb, n0 = 32 * nb;
    float tv[32];
    { const GAS float* wp = (const GAS float*)(W + (size_t)(k0 + (lane >> 5)) * N + n0 + (lane & 31));
#pragma unroll
      for (int i = 0; i < 32; ++i) tv[i] = wp[(size_t)(2 * i) * N]; }
#pragma unroll
    for (int i = 0; i < 32; ++i) scr[(2 * i + (lane >> 5)) * 33 + (lane & 31)] = tv[i];
    LDS_WAIT(); asm volatile("" ::: "memory");
    const int c = lane & 7;
#pragma unroll
    for (int j = 0; j < 4; ++j) { const int n = (lane >> 3) + 8 * j; const LAS float* s = scr + (8 * c) * 33 + n;
        v4u o; o.x = pk2(s[0 * 33], s[1 * 33]); o.y = pk2(s[2 * 33], s[3 * 33]); o.z = pk2(s[4 * 33], s[5 * 33]); o.w = pk2(s[6 * 33], s[7 * 33]);
        *(GAS v4u*)(WT + (size_t)mp(n0 + n) * ldk + koff + k0 + 8 * c) = o; }
    LDS_WAIT(); asm volatile("" ::: "memory");
}

struct Args { const float* in[22]; float* out; unsigned char* ws; int ph_lo, ph_hi, li, pad; };

struct EpiSwiglu {
    static constexpr bool PERM = true; static constexpr bool HAS_MID = false;
    bf16* O;
    __device__ __forceinline__ void operator()(const pg8::f32x4 (&acc)[2][2][4][2], const pg8::Unit& u, int wr, int wc, int fr, int fq) const {
        const int row0 = u.pm * 256 + wr * 64 + fr, col0 = u.pn * 128 + wc * 32 + 8 * fq;
        bf16* base = O + (size_t)row0 * FF + col0;
#pragma unroll
        for (int ai = 0; ai < 2; ++ai)
#pragma unroll
            for (int m = 0; m < 4; ++m) {
                pg8::u32x4 w;
                { const pg8::f32x4 g = acc[ai][0][m][0], uu = acc[ai][1][m][0];
                  w.x = pg8::cvt_pk_bf16(silu_f(g[0]) * uu[0], silu_f(g[1]) * uu[1]); w.y = pg8::cvt_pk_bf16(silu_f(g[2]) * uu[2], silu_f(g[3]) * uu[3]); }
                { const pg8::f32x4 g = acc[ai][0][m][1], uu = acc[ai][1][m][1];
                  w.z = pg8::cvt_pk_bf16(silu_f(g[0]) * uu[0], silu_f(g[1]) * uu[1]); w.w = pg8::cvt_pk_bf16(silu_f(g[2]) * uu[2], silu_f(g[3]) * uu[3]); }
                *(pg8::u32x4*)(base + (size_t)(ai * 128 + m * 16) * FF) = w;
                asm volatile("" ::: "memory");
            }
    }
};
struct EpiResid {
    static constexpr bool PERM = false; static constexpr bool HAS_MID = false;
    const float* xin; float* xout; const float* gate;
    float coef;
    __device__ __forceinline__ void operator()(const pg8::f32x4 (&acc)[2][2][4][2], const pg8::Unit& u, int wr, int wc, int fr, int fq) const {
        const int b = u.pm >> 4;
        const int row0 = u.pm * 256 + wr * 64 + fr, col0 = u.pn * 256 + wc * 32 + 4 * fq;
        pg8::f32x4 gv[2][2];
#pragma unroll
        for (int bj = 0; bj < 2; ++bj)
#pragma unroll
            for (int n = 0; n < 2; ++n) gv[bj][n] = *(const pg8::f32x4*)(gate + (size_t)b * NMOD + col0 + bj * 128 + n * 16) * coef;
#pragma unroll
        for (int ai = 0; ai < 2; ++ai)
#pragma unroll
            for (int m = 0; m < 4; ++m) { const size_t off = (size_t)(row0 + ai * 128 + m * 16) * D + col0;
#pragma unroll
                for (int bj = 0; bj < 2; ++bj)
#pragma unroll
                    for (int n = 0; n < 2; ++n) { const pg8::f32x4 xv = *(const pg8::f32x4*)(xin + off + bj * 128 + n * 16);
                        *(pg8::f32x4*)(xout + off + bj * 128 + n * 16) = xv + gv[bj][n] * acc[ai][bj][m][n]; }
                if (m & 1) asm volatile("" ::: "memory"); }
    }
};

__device__ __forceinline__ void modulate_phase(Frame& F, const float* x, bf16* H, const float* gnorm, const float* modsub) {
    const int gw = F.vcu * NWAVES + F.wave, NGW = F.G * NWAVES, per = (M + NGW - 1) / NGW;
    const int rbeg = gw * per, rend = min(rbeg + per, M);
    if (rbeg >= rend) return;
    f32x4 gs[8], sh[8]; int curb = -1;
    f32x4 v[8], nv[8];
    { const GAS f32x4* xr = (const GAS f32x4*)(x + (size_t)rbeg * D) + F.lane;
#pragma unroll
      for (int j = 0; j < 8; ++j) v[j] = xr[64 * j]; }
#pragma unroll 1
    for (int r = rbeg; r < rend; ++r) {
        { const GAS f32x4* xn = (const GAS f32x4*)(x + (size_t)min(r + 1, rend - 1) * D) + F.lane;
#pragma unroll
          for (int j = 0; j < 8; ++j) nv[j] = xn[64 * j]; }
        const int b = r >> 12;
        if (b != curb) { curb = b;
#pragma unroll
            for (int j = 0; j < 8; ++j) { const int c = 4 * F.lane + 256 * j;
                const f32x4 g = *(const GAS f32x4*)(gnorm + c), sc = *(const GAS f32x4*)(modsub + (size_t)b * NMOD + D + c);
                gs[j] = g * (sc + 1.0f); sh[j] = *(const GAS f32x4*)(modsub + (size_t)b * NMOD + c); } }
        float s = 0.f;
#pragma unroll
        for (int j = 0; j < 8; ++j) s += (v[j].x * v[j].x + v[j].y * v[j].y) + (v[j].z * v[j].z + v[j].w * v[j].w);
        const float rstd = 1.0f / sqrtf(wave_sum(s) * (1.0f / D) + RMS_EPS);
        GAS unsigned long long* o8 = (GAS unsigned long long*)(H + (size_t)r * D) + F.lane;
#pragma unroll
        for (int j = 0; j < 8; ++j) { const f32x4 y = v[j] * rstd * gs[j] + sh[j];
            o8[64 * j] = (unsigned long long)pk2(y.x, y.y) | ((unsigned long long)pk2(y.z, y.w) << 32); }
#pragma unroll
        for (int j = 0; j < 8; ++j) v[j] = nv[j];
    }
}
__device__ __forceinline__ void final_norm_phase(Frame& F, const float* x, float* out, const float* gfin) {
    const int gw = F.vcu * NWAVES + F.wave, NGW = F.G * NWAVES;
    f32x4 gs[8];
#pragma unroll
    for (int j = 0; j < 8; ++j) gs[j] = *(const GAS f32x4*)(gfin + 4 * F.lane + 256 * j);
    for (int r = gw; r < M; r += NGW) {
        const GAS f32x4* xr = (const GAS f32x4*)(x + (size_t)r * D) + F.lane;
        f32x4 v[8]; float s = 0.f;
#pragma unroll
        for (int j = 0; j < 8; ++j) { v[j] = xr[64 * j]; s += (v[j].x * v[j].x + v[j].y * v[j].y) + (v[j].z * v[j].z + v[j].w * v[j].w); }
        const float rstd = 1.0f / sqrtf(wave_sum(s) * (1.0f / D) + RMS_EPS);
        GAS f32x4* o = (GAS f32x4*)(out + (size_t)r * D) + F.lane;
#pragma unroll
        for (int j = 0; j < 8; ++j) { f32x4 y = v[j] * rstd * gs[j];
#ifdef DIAG_SANITIZE
            y.x = (y.x == y.x && fabsf(y.x) < 1e30f) ? y.x : 0.f; y.y = (y.y == y.y && fabsf(y.y) < 1e30f) ? y.y : 0.f; y.z = (y.z == y.z && fabsf(y.z) < 1e30f) ? y.z : 0.f; y.w = (y.w == y.w && fabsf(y.w) < 1e30f) ? y.w : 0.f;
#endif
            o[64 * j] = y; }
    }
}

struct EpiWin {
    static constexpr bool PERM = true; static constexpr bool HAS_MID = false;
    unsigned char* ws;
    __device__ __forceinline__ void operator()(const pg8::f32x4 (&acc)[2][2][4][2], const pg8::Unit& u, int wr, int wc, int fr, int fq) const {
        const int b = u.pm >> 4, s0 = (u.pm & 15) * 256 + wr * 64 + fr, pn = u.pn;
        const size_t row0 = (size_t)b * SEQ + s0;
#pragma unroll
        for (int bj = 0; bj < 2; ++bj) {
            const int c0 = pn * 256 + bj * 128 + wc * 32 + 8 * fq;
            int mode = 0; bf16* d16 = nullptr; float* d32 = nullptr; size_t rs = 0; float sc = 1.f;
            if (pn < 4) { d16 = (bf16*)(ws + WS_QN) + ((size_t)(b * 16 + (c0 >> 6)) * SEQ + s0) * 64 + (c0 & 63); rs = 64; sc = QSCALE; }
            else if (pn < 10) { const int c = c0 - 1024; d16 = (bf16*)(ws + WS_KV) + ((size_t)(((c >> 8) * NB + b) * 4 + ((c >> 6) & 3)) * SEQ + s0) * 64 + (c & 63); rs = 64; }
            else if (pn < 14) { d16 = (bf16*)(ws + WS_QD) + row0 * 1024 + (c0 - 2560); rs = 1024; }
            else if (pn == 14) { d32 = (float*)(ws + WS_CKVR) + row0 * 256 + (c0 - 3584); rs = 256; mode = 2; }
            else if (pn < 17) { d16 = (bf16*)(ws + WS_QI) + row0 * 512 + (c0 - 3840); rs = 512; }
            else if (pn == 17) { const int c = c0 - 4352;
                if (c < 32) { d16 = (bf16*)(ws + WS_KI) + row0 * 32 + c; rs = 32; }
                else if (c < 48) { d32 = (float*)(ws + WS_WI) + row0 * 16 + (c - 32); rs = 16; mode = 2; sc = INDEX_SCALE; }
                else if (c < 96) { d32 = (float*)(ws + WS_GN) + row0 * 48 + (c - 48); rs = 48; mode = 3; }
                else mode = 5; }
            else { d16 = (bf16*)(ws + WS_AM) + row0 * 4096 + (c0 - 4608); rs = 4096; mode = 1; }
            if (mode == 5) continue;
#pragma unroll
            for (int ai = 0; ai < 2; ++ai)
#pragma unroll
                for (int m = 0; m < 4; ++m) {
                    pg8::f32x4 v0 = acc[ai][bj][m][0], v1 = acc[ai][bj][m][1];
                    if (mode & 1) { v0 = (pg8::f32x4){sigmoid_f(v0[0]), sigmoid_f(v0[1]), sigmoid_f(v0[2]), sigmoid_f(v0[3])}; v1 = (pg8::f32x4){sigmoid_f(v1[0]), sigmoid_f(v1[1]), sigmoid_f(v1[2]), sigmoid_f(v1[3])}; }
                    else { v0 = v0 * sc; v1 = v1 * sc; }
                    const size_t ro = (size_t)(ai * 128 + m * 16) * rs;
                    if (mode < 2) { pg8::u32x4 w; w.x = pg8::cvt_pk_bf16(v0[0], v0[1]); w.y = pg8::cvt_pk_bf16(v0[2], v0[3]); w.z = pg8::cvt_pk_bf16(v1[0], v1[1]); w.w = pg8::cvt_pk_bf16(v1[2], v1[3]);
                        *(pg8::u32x4*)(d16 + ro) = w; }
                    else { *(pg8::f32x4*)(d32 + ro) = v0; *(pg8::f32x4*)(d32 + ro + 4) = v1; }
                    asm volatile("" ::: "memory");
                }
        }
    }
};
struct EpiCmp1 {
    static constexpr bool PERM = true; static constexpr bool HAS_MID = false;
    bf16* O; const float* b1;
    __device__ __forceinline__ void operator()(const pg8::f32x4 (&acc)[2][2][4][2], const pg8::Unit& u, int wr, int wc, int fr, int fq) const {
        const int row0 = u.pm * 256 + wr * 64 + fr;
#pragma unroll
        for (int bj = 0; bj < 2; ++bj) {
            const int col0 = bj * 128 + wc * 32 + 8 * fq;
            const pg8::f32x4 bA = *(const pg8::f32x4*)(b1 + u.pn * 256 + col0), bB = *(const pg8::f32x4*)(b1 + u.pn * 256 + col0 + 4);
#pragma unroll
            for (int ai = 0; ai < 2; ++ai)
#pragma unroll
                for (int m = 0; m < 4; ++m) {
                    const pg8::f32x4 v0 = acc[ai][bj][m][0] + bA, v1 = acc[ai][bj][m][1] + bB;
                    pg8::u32x4 w; w.x = pg8::cvt_pk_bf16(silu_f(v0[0]), silu_f(v0[1])); w.y = pg8::cvt_pk_bf16(silu_f(v0[2]), silu_f(v0[3]));
                    w.z = pg8::cvt_pk_bf16(silu_f(v1[0]), silu_f(v1[1])); w.w = pg8::cvt_pk_bf16(silu_f(v1[2]), silu_f(v1[3]));
                    *(pg8::u32x4*)(O + (size_t)(row0 + ai * 128 + m * 16) * 256 + col0) = w;
                    asm volatile("" ::: "memory");
                }
        }
    }
};
struct CmpOrder {
    int G, c;
    __device__ __forceinline__ bool next(int i, pg8::Unit& u) const { const int L = i * G + c; if (L >= 32) return false; u.pm = L; u.pn = L >> 4; return true; }
    __device__ __forceinline__ void a_ready(const pg8::Unit&) const {}
    __device__ __forceinline__ void done(const pg8::Unit&) const {}
};
struct EpiUpF {
    static constexpr bool PERM = false; static constexpr bool HAS_MID = true;
    const bf16* AM; bf16* Y;
    static __device__ __forceinline__ pg8::f32x4 up4(pg8::u32x2 a) { return (pg8::f32x4){__uint_as_float(a.x << 16), __uint_as_float(a.x & 0xffff0000u), __uint_as_float(a.y << 16), __uint_as_float(a.y & 0xffff0000u)}; }
    __device__ __forceinline__ void mid(pg8::f32x4 (&acc)[2][2][4][2], const pg8::Unit& u, int wr, int wc, int fr, int fq) const {
        int row0 = u.pm * 256 + wr * 64 + fr, col0 = u.pn * 256 + wc * 32 + 4 * fq;
        asm volatile("" : "+v"(row0), "+v"(col0));
#pragma unroll
        for (int ai = 0; ai < 2; ++ai)
#pragma unroll
            for (int m = 0; m < 4; ++m) { const bf16* ap = AM + (size_t)(row0 + ai * 128 + m * 16) * 4096 + col0;
#pragma unroll
                for (int bj = 0; bj < 2; ++bj)
#pragma unroll
                    for (int n = 0; n < 2; ++n) { const int c = bj * 128 + n * 16;
                        const pg8::f32x4 a0 = up4(*(const pg8::u32x2*)(ap + c)), a1 = up4(*(const pg8::u32x2*)(ap + 2048 + c));
                        pg8::f32x4 r; r[0] = a0[0] * __builtin_amdgcn_rcpf(fmaxf(a1[0], 1e-30f)); r[1] = a0[1] * __builtin_amdgcn_rcpf(fmaxf(a1[1], 1e-30f)); r[2] = a0[2] * __builtin_amdgcn_rcpf(fmaxf(a1[2], 1e-30f)); r[3] = a0[3] * __builtin_amdgcn_rcpf(fmaxf(a1[3], 1e-30f));
                        acc[ai][bj][m][n] = acc[ai][bj][m][n] * r; }
                asm volatile("" ::: "memory"); }
    }
    __device__ __forceinline__ void operator()(const pg8::f32x4 (&acc)[2][2][4][2], const pg8::Unit& u, int wr, int wc, int fr, int fq) const {
        const int row0 = u.pm * 256 + wr * 64 + fr, col0 = u.pn * 256 + wc * 32 + 4 * fq;
#pragma unroll
        for (int ai = 0; ai < 2; ++ai)
#pragma unroll
            for (int m = 0; m < 4; ++m) { const size_t r = (size_t)(row0 + ai * 128 + m * 16);
#pragma unroll
                for (int bj = 0; bj < 2; ++bj)
#pragma unroll
                    for (int n = 0; n < 2; ++n) { const int c = col0 + bj * 128 + n * 16;
                        const pg8::f32x4 y = up4(*(const pg8::u32x2*)(AM + r * 4096 + 2048 + c)) * acc[ai][bj][m][n];
                        pg8::u32x2 w; w.x = pg8::cvt_pk_bf16(y[0], y[1]); w.y = pg8::cvt_pk_bf16(y[2], y[3]);
                        *(pg8::u32x2*)(Y + r * D + c) = w; }
                asm volatile("" ::: "memory"); }
    }
};

typedef float f32x16 __attribute__((ext_vector_type(16)));
typedef short s16x4 __attribute__((ext_vector_type(4)));
typedef unsigned long long u64;
#define MFMA16(a, b, c) __builtin_amdgcn_mfma_f32_16x16x32_bf16((a), (b), (c), 0, 0, 0)
#define MFMA32(a, b, c) __builtin_amdgcn_mfma_f32_32x32x16_bf16((a), (b), (c), 0, 0, 0)

__device__ __forceinline__ void ckvnorm_rows(const float* raw, bf16* out, const float* gkv, int w0, int nw, int lane) {
    const f32x4 g = *(const GAS f32x4*)(gkv + 4 * lane);
#pragma unroll 1
    for (int r = w0; r < M; r += 4 * nw) {
        f32x4 v[4];
#pragma unroll
        for (int u = 0; u < 4; ++u) { const int rr = min(r + u * nw, M - 1); v[u] = *(const GAS f32x4*)(raw + (size_t)rr * 256 + 4 * lane); }
#pragma unroll
        for (int u = 0; u < 4; ++u) { const int rr = r + u * nw;
            const float ss = wave_sum((v[u].x * v[u].x + v[u].y * v[u].y) + (v[u].z * v[u].z + v[u].w * v[u].w));
            const float rstd = 1.0f / sqrtf(ss * (1.0f / 256.0f) + RMS_EPS);
            const f32x4 y = v[u] * rstd * g;
            if (rr < M) *(GAS unsigned long long*)(out + (size_t)rr * 256 + 4 * lane) = (unsigned long long)pk2(y.x, y.y) | ((unsigned long long)pk2(y.z, y.w) << 32); }
    }
}
__device__ __forceinline__ void qlat_items(const bf16* QD, const bf16* WUK, bf16* QLAT, int pair, int npairs, int sub, int wave, int lane) {
    const int fr = lane & 15, fq = lane >> 4, h = sub * 8 + wave;
    bf16x8 wa[16][2];
#pragma unroll
    for (int pm = 0; pm < 16; ++pm) { const int c = 64 * (pm >> 2) + 32 * ((pm >> 1) & 1) + 8 * (fr >> 2) + 4 * (pm & 1) + (fr & 3);
#pragma unroll
        for (int ks = 0; ks < 2; ++ks) wa[pm][ks] = *(const GAS bf16x8*)(WUK + (size_t)c * 1024 + h * 64 + 32 * ks + 8 * fq); }
    const bf16* qp = QD + (size_t)fr * 1024 + h * 64 + 8 * fq;
    bf16* op = QLAT + (size_t)fr * 4096 + h * 256 + 8 * fq;
    bf16x8 q0, q1, n0, n1;
    if (pair < M / 16) { q0 = *(const GAS bf16x8*)(qp + (size_t)pair * 16 * 1024); q1 = *(const GAS bf16x8*)(qp + (size_t)pair * 16 * 1024 + 32); }
#pragma unroll 1
    for (int tile = pair; tile < M / 16; tile += npairs) {
        const int nt = min(tile + npairs, M / 16 - 1);
        n0 = *(const GAS bf16x8*)(qp + (size_t)nt * 16 * 1024); n1 = *(const GAS bf16x8*)(qp + (size_t)nt * 16 * 1024 + 32);
        bf16* o = op + (size_t)tile * 16 * 4096;
#pragma unroll
        for (int ps = 0; ps < 8; ++ps) {
            f32x4 d0 = MFMA16(wa[2 * ps][0], q0, ((f32x4){0.f, 0.f, 0.f, 0.f})); d0 = MFMA16(wa[2 * ps][1], q1, d0);
            f32x4 d1 = MFMA16(wa[2 * ps + 1][0], q0, ((f32x4){0.f, 0.f, 0.f, 0.f})); d1 = MFMA16(wa[2 * ps + 1][1], q1, d1);
            pg8::u32x4 w; w.x = cvtpk(d0[0], d0[1]); w.y = cvtpk(d0[2], d0[3]); w.z = cvtpk(d1[0], d1[1]); w.w = cvtpk(d1[2], d1[3]);
            *(GAS pg8::u32x4*)(o + 32 * ps) = w;
        }
        q0 = n0; q1 = n1;
    }
}
__device__ __forceinline__ void cmp2_items(const bf16* Hd, const bf16* W2T, bf16* OUT, int it0, int it1, int w0, int nw, int lane) {
    const int fr = lane & 15, fq = lane >> 4, kv = (it0 * 16) >> 12;
    if (it0 + w0 >= it1) return;
    bf16x8 wa[4][8], hb[8];
#pragma unroll
    for (int ks = 0; ks < 8; ++ks) hb[ks] = *(const GAS bf16x8*)(Hd + (size_t)((it0 + w0) * 16 + fr) * 256 + 32 * ks + 8 * fq);
#pragma unroll
    for (int dt = 0; dt < 4; ++dt)
#pragma unroll
        for (int ks = 0; ks < 8; ++ks) wa[dt][ks] = *(const GAS bf16x8*)(W2T + (size_t)(kv * 64 + 16 * dt + fr) * 256 + 32 * ks + 8 * fq);
#pragma unroll 1
    for (int it = it0 + w0; it < it1; it += nw) {
        const int r0 = it * 16, nx = min(it + nw, it1 - 1);
        bf16x8 nb[8];
#pragma unroll
        for (int ks = 0; ks < 8; ++ks) nb[ks] = *(const GAS bf16x8*)(Hd + (size_t)(nx * 16 + fr) * 256 + 32 * ks + 8 * fq);
#pragma unroll
        for (int dt = 0; dt < 4; ++dt) {
            f32x4 d = {0.f, 0.f, 0.f, 0.f};
#pragma unroll
            for (int ks = 0; ks < 8; ++ks) d = MFMA16(wa[dt][ks], hb[ks], d);
            *(GAS unsigned long long*)(OUT + (size_t)(r0 + fr) * 64 + 16 * dt + 4 * fq) = (unsigned long long)cvtpk(d[0], d[1]) | ((unsigned long long)cvtpk(d[2], d[3]) << 32);
        }
#pragma unroll
        for (int ks = 0; ks < 8; ++ks) hb[ks] = nb[ks];
    }
}
__device__ __forceinline__ void od_items(const bf16* OLAT, const bf16* WUVT, bf16* OD, int vcu, int G, int wave, int lane) {
    const int fr = lane & 15, fq = lane >> 4, h = (vcu & 1) * 8 + wave;
    bf16x8 wa[4][8];
#pragma unroll
    for (int m = 0; m < 4; ++m) { const int d = 32 * (m >> 1) + 8 * (fr >> 2) + 4 * (m & 1) + (fr & 3);
#pragma unroll
        for (int ks = 0; ks < 8; ++ks) wa[m][ks] = *(const GAS bf16x8*)(WUVT + (size_t)(h * 64 + d) * 256 + 32 * ks + 8 * fq); }
#pragma unroll 1
  for (int tb = (vcu >> 1) * 128; tb < M; tb += (G >> 1) * 128) {
    const bf16* ip = OLAT + (size_t)(tb + fr) * 4096 + h * 256 + 8 * fq;
    bf16* op = OD + (size_t)(tb + fr) * 2048 + 1024 + h * 64 + 8 * fq;
    bf16x8 ob[8], nb[8];
#pragma unroll
    for (int ks = 0; ks < 8; ++ks) ob[ks] = *(const GAS bf16x8*)(ip + 32 * ks);
#pragma unroll 1
    for (int tile = 0; tile < 8; ++tile) {
        const bf16* np = ip + (size_t)min(tile + 1, 7) * 16 * 4096;
#pragma unroll
        for (int ks = 0; ks < 8; ++ks) nb[ks] = *(const GAS bf16x8*)(np + 32 * ks);
        f32x4 d[4];
#pragma unroll
        for (int m = 0; m < 4; ++m) { d[m] = (f32x4){0.f, 0.f, 0.f, 0.f};
#pragma unroll
            for (int ks = 0; ks < 8; ++ks) d[m] = MFMA16(wa[m][ks], ob[ks], d[m]); }
#pragma unroll
        for (int sI = 0; sI < 2; ++sI) { pg8::u32x4 w; w.x = cvtpk(d[2 * sI][0], d[2 * sI][1]); w.y = cvtpk(d[2 * sI][2], d[2 * sI][3]); w.z = cvtpk(d[2 * sI + 1][0], d[2 * sI + 1][1]); w.w = cvtpk(d[2 * sI + 1][2], d[2 * sI + 1][3]);
            *(GAS pg8::u32x4*)(op + (size_t)tile * 16 * 2048 + 32 * sI) = w; }
#pragma unroll
        for (int ks = 0; ks < 8; ++ks) ob[ks] = nb[ks];
    }
  }
}

constexpr int NS_K = 0, NS_V = 16384, NS_IMP = 32768, NS_MASK = NS_IMP + 65536;
constexpr int LUTN_OFF = EXTRA_OFF, LUTD_OFF = EXTRA_OFF + 8192, IDXL_OFF = EXTRA_OFF + 16384;
__device__ __forceinline__ int mbcnt64(u64 m) { return __builtin_amdgcn_mbcnt_hi((unsigned)(m >> 32), __builtin_amdgcn_mbcnt_lo((unsigned)m, 0u)); }
__device__ __forceinline__ int crow(int r, int hi) { return (r & 3) + 8 * (r >> 2) + 4 * hi; }
__device__ __forceinline__ int t5_bucket(int n) { return n < 16 ? n : min(31, 16 + (int)(logf((float)n * (1.0f / 16.0f)) / 2.0794415416798357f * 16.0f)); }
__device__ __forceinline__ void build_luts(Frame& F, const float* relb) {
    LAS float* ln = (LAS float*)(F.lds + LUTN_OFF); LAS float* ld = (LAS float*)(F.lds + LUTD_OFF);
    for (int i = F.tid; i < 16 * 128; i += NWAVES * 64) { const int h = i >> 7, bk = t5_bucket(i & 127); ln[i] = relb[bk * 32 + h] * LOG2E; ld[i] = relb[bk * 32 + 16 + h] * LOG2E; }
    __syncthreads();
}
struct NsaSm { float m, l; };
__device__ __forceinline__ void nsa_scores(f32x16& p0, f32x16& p1, LAS const unsigned char* Kt, const bf16x8 (&qr)[4], float cin, int r32, int hi) {
#pragma unroll
    for (int r = 0; r < 16; ++r) { p0[r] = cin; p1[r] = cin; }
    const int sw = (r32 >> 1) & 7;
    LAS const unsigned char* k0 = Kt + r32 * 128; LAS const unsigned char* k1 = k0 + 32 * 128;
#pragma unroll
    for (int d0 = 0; d0 < 4; ++d0) {
        const int ch = ((2 * d0 + hi) ^ sw) << 4;
        const bf16x8 a0 = *(LAS const bf16x8*)(k0 + ch), a1 = *(LAS const bf16x8*)(k1 + ch);
        p0 = MFMA32(a0, qr[d0], p0); p1 = MFMA32(a1, qr[d0], p1);
    }
}
__device__ __forceinline__ void nsa_near(f32x16& p0, f32x16& p1, int dbase, int stride, int lim, LAS const float* lut, int hi) {
    int db = dbase - stride * 4 * hi; asm volatile("" : "+v"(db));
#pragma unroll
    for (int r = 0; r < 16; ++r) {
        const int d0 = db - stride * ((r & 3) + 8 * (r >> 2)), d1 = d0 - stride * 32;
        const float b0 = lut[min(max(d0, 0), 127)], b1 = lut[min(max(d1, 0), 127)];
        p0[r] = (d0 >= 0 && d0 < lim) ? p0[r] + b0 : -INFINITY; p1[r] = (d1 >= 0 && d1 < lim) ? p1[r] + b1 : -INFINITY;
    }
}
__device__ __forceinline__ float nsa_rowmax(const f32x16& p0, const f32x16& p1) {
    float a = __builtin_elementwise_maximum(p0[0], p1[0]);
#pragma unroll
    for (int r = 1; r < 16; ++r) a = __builtin_elementwise_maximum(a, __builtin_elementwise_maximum(p0[r], p1[r]));
    return xmax32(a);
}
__device__ __forceinline__ void nsa_pv(f32x16& o0, f32x16& o1, LAS const unsigned char* Vt, const bf16x8 (&pk)[4], int lane) {
    const int hi = lane >> 5, G = (lane >> 4) & 1, q_ = (lane & 15) >> 2, p_ = lane & 3;
    const int sw = ((q_ >> 1) & 1) << 2;
    const int rowoff = (4 * hi + q_) * 128 + (p_ & 1) * 8;
    const int c0 = (((2 * G + (p_ >> 1)) ^ sw) << 4), c1 = (((4 + 2 * G + (p_ >> 1)) ^ sw) << 4);
#pragma unroll
    for (int sb = 0; sb < 2; ++sb) {
        s16x4 al[2][2], ah[2][2];
#pragma unroll
        for (int s2 = 0; s2 < 2; ++s2) { LAS const unsigned char* base = Vt + (2 * sb + s2) * 16 * 128 + rowoff;
            al[s2][0] = __builtin_bit_cast(s16x4, __builtin_amdgcn_ds_read_tr16_b64_v4i16((LAS s16x4*)(base + c0)));
            ah[s2][0] = __builtin_bit_cast(s16x4, __builtin_amdgcn_ds_read_tr16_b64_v4i16((LAS s16x4*)(base + c0 + 8 * 128)));
            al[s2][1] = __builtin_bit_cast(s16x4, __builtin_amdgcn_ds_read_tr16_b64_v4i16((LAS s16x4*)(base + c1)));
            ah[s2][1] = __builtin_bit_cast(s16x4, __builtin_amdgcn_ds_read_tr16_b64_v4i16((LAS s16x4*)(base + c1 + 8 * 128))); }
#pragma unroll
        for (int s2 = 0; s2 < 2; ++s2) {
            const bf16x8 v0 = {al[s2][0][0], al[s2][0][1], al[s2][0][2], al[s2][0][3], ah[s2][0][0], ah[s2][0][1], ah[s2][0][2], ah[s2][0][3]};
            const bf16x8 v1 = {al[s2][1][0], al[s2][1][1], al[s2][1][2], al[s2][1][3], ah[s2][1][0], ah[s2][1][1], ah[s2][1][2], ah[s2][1][3]};
            o0 = MFMA32(v0, pk[2 * sb + s2], o0); o1 = MFMA32(v1, pk[2 * sb + s2], o1); }
    }
}
__device__ __forceinline__ void nsa_pack(bf16x8 (&pk)[4], const f32x16& p0, const f32x16& p1) {
#pragma unroll
    for (int s = 0; s < 2; ++s) {
        pg8::u32x4 w0, w1;
        w0.x = cvtpk(p0[8 * s + 0], p0[8 * s + 1]); w0.y = cvtpk(p0[8 * s + 2], p0[8 * s + 3]); w0.z = cvtpk(p0[8 * s + 4], p0[8 * s + 5]); w0.w = cvtpk(p0[8 * s + 6], p0[8 * s + 7]);
        w1.x = cvtpk(p1[8 * s + 0], p1[8 * s + 1]); w1.y = cvtpk(p1[8 * s + 2], p1[8 * s + 3]); w1.z = cvtpk(p1[8 * s + 4], p1[8 * s + 5]); w1.w = cvtpk(p1[8 * s + 6], p1[8 * s + 7]);
        pk[s] = __builtin_bit_cast(bf16x8, w0); pk[2 + s] = __builtin_bit_cast(bf16x8, w1);
    }
}
__device__ __forceinline__ void nsa_online(f32x16& p0, f32x16& p1, NsaSm& st, f32x16& o0, f32x16& o1, LAS const unsigned char* Vt, int lane, float cin) {
    const float mx = nsa_rowmax(p0, p1) + cin, mn = fmaxf(st.m, mx), alpha = __builtin_amdgcn_exp2f(st.m - mn), off = mn - cin;
    st.m = mn; float sum = 0.f;
#pragma unroll
    for (int r = 0; r < 16; ++r) { p0[r] = __builtin_amdgcn_exp2f(p0[r] - off); p1[r] = __builtin_amdgcn_exp2f(p1[r] - off); sum += p0[r] + p1[r]; }
    st.l = st.l * alpha + sum;
    if (__any(alpha != 1.0f)) {
#pragma unroll
        for (int r = 0; r < 16; ++r) { o0[r] *= alpha; o1[r] *= alpha; } }
    bf16x8 pk[4]; nsa_pack(pk, p0, p1);
    nsa_pv(o0, o1, Vt, pk, lane);
}
__device__ __forceinline__ void nsa_stage_store(LAS unsigned char* lds, int buf, int tid, const v4u& kr, const v4u& vr) {
    const int key = tid >> 3, ch = tid & 7;
    *(LAS v4u*)(lds + NS_K + buf * 8192 + key * 128 + ((ch ^ ((key >> 1) & 7)) << 4)) = kr;
    *(LAS v4u*)(lds + NS_V + buf * 8192 + key * 128 + ((ch ^ (((key >> 1) & 1) << 2)) << 4)) = vr;
}

__device__ __forceinline__ void nsa_unit(Frame& F, int b, int g, int i, const bf16* QN, const bf16* KV, const bf16* KCMP, const float* GN, bf16* ON, int& itc) {
    const int tid = F.tid, lane = F.lane, r32 = lane & 31, hi = lane >> 5, hh = F.wave & 3, th = F.wave >> 2, h = 4 * g + hh;
    const int t0 = 64 * i, tw0 = t0 + 32 * th, t = tw0 + r32;
    LAS unsigned char* lds = F.lds + RING_OFF;
    LAS const float* lut = (LAS const float*)(F.lds + LUTN_OFF) + h * 128;
    const float b31 = lut[127];
    bf16x8 qr[4];
#pragma unroll
    for (int d0 = 0; d0 < 4; ++d0) qr[d0] = *(const GAS bf16x8*)(QN + ((size_t)(b * 16 + h) * SEQ + t) * 64 + 16 * d0 + 8 * hi);
    const float* gp = GN + (size_t)(b * SEQ + t) * 48 + h * 3;
    const float g0 = gp[0], g1 = gp[1], g2 = gp[2];
    const int bg = b * 4 + g;
    const bf16 *Kc, *Vc, *Ks, *Vs, *Kw, *Vw;
    f32x16 oc0, oc1;
    LAS float* accl = (LAS float*)(lds + NS_IMP) + F.wave * 2048 + lane;
    v4u kr, vr; const unsigned toff = (unsigned)tid * 16u;
#define NSA_LOAD(Kp, Vp, jb) do { kr = *(const GAS v4u*)((const GAS char*)((Kp) + (size_t)(jb) * 4096) + toff); vr = *(const GAS v4u*)((const GAS char*)((Vp) + (size_t)(jb) * 4096) + toff); } while (0)
#define NSA_STAGE() do { nsa_stage_store(lds, itc & 1, tid, kr, vr); } while (0)
#define NSA_BAR() asm volatile("s_waitcnt lgkmcnt(0)\n\ts_barrier" ::: "memory")
#define NSA_KT (lds + NS_K + (itc & 1) * 8192)
#define NSA_VT (lds + NS_V + (itc & 1) * 8192)
    const int ncb = ((min((t0 + 32) >> 4, 254)) >> 6) + 1;
    NsaSm sc{-1e30f, 0.f};
    Kc = launder(KCMP) + (size_t)bg * 256 * 64; Vc = Kc + (size_t)16 * 256 * 64;
    NSA_LOAD(Kc, Vc, 0);
    for (int jb = 0; jb < ncb; ++jb) {
        NSA_STAGE(); if (jb + 1 < ncb) NSA_LOAD(Kc, Vc, jb + 1); else NSA_LOAD(Kc, Vc, 0);
        NSA_BAR();
        f32x16 p0, p1;
        const int dmin = tw0 - 31 - 16 * (64 * jb + 63);
        nsa_scores(p0, p1, NSA_KT, qr, 0.f, r32, hi);
        float cin = b31;
        if (dmin < 113) { nsa_near(p0, p1, t - 31 - 1024 * jb, 16, 1 << 30, lut, hi); cin = 0.f; }
        const float mx = nsa_rowmax(p0, p1) + cin, mn = fmaxf(sc.m, mx), alpha = __builtin_amdgcn_exp2f(sc.m - mn), off = mn - cin;
        sc.m = mn; float sum = 0.f;
#pragma unroll
        for (int r = 0; r < 16; ++r) sum += __builtin_amdgcn_exp2f(p0[r] - off) + __builtin_amdgcn_exp2f(p1[r] - off);
        sc.l = sc.l * alpha + sum;
        ++itc;
    }
    {
        const float lt = xsum32(sc.l), inv = lt > 0.f ? 1.0f / lt : 0.f;
        f32x16 o0, o1;
#pragma unroll
        for (int r = 0; r < 16; ++r) { o0[r] = 0.f; o1[r] = 0.f; }
        float carry = 0.f;
        LAS float* imp = (LAS float*)(lds + NS_IMP) + (hh * 64 + 32 * th + r32) * 64;
#pragma unroll 1
        for (int jb = 0; jb < 4; ++jb) {
            float X[8];
#pragma unroll
            for (int a = 0; a < 8; ++a) X[a] = 0.f;
            if (jb < ncb) {
                NSA_STAGE(); if (jb + 1 < ncb) NSA_LOAD(Kc, Vc, jb + 1);
                NSA_BAR();
                f32x16 p0, p1;
                const int dmin = tw0 - 31 - 16 * (64 * jb + 63);
                nsa_scores(p0, p1, NSA_KT, qr, 0.f, r32, hi);
                float off = sc.m - b31;
                if (dmin < 113) { nsa_near(p0, p1, t - 31 - 1024 * jb, 16, 1 << 30, lut, hi); off = sc.m; }
#pragma unroll
                for (int r = 0; r < 16; ++r) { p0[r] = __builtin_amdgcn_exp2f(p0[r] - off) * inv; p1[r] = __builtin_amdgcn_exp2f(p1[r] - off) * inv; }
                X[0] = hi ? 0.f : carry;
#pragma unroll
                for (int a = 0; a < 8; ++a) {
                    const int ra = 4 * (a & 3);
                    const float e0 = a < 4 ? p0[ra] : p1[ra], e1 = a < 4 ? p0[ra + 1] : p1[ra + 1], e2 = a < 4 ? p0[ra + 2] : p1[ra + 2], e3 = a < 4 ? p0[ra + 3] : p1[ra + 3];
                    const float other = xget32(e3, hi != 0);
                    X[a] += (e0 + e1) + (e2 + e3);
                    if (hi) X[a] += other; else { if (a < 7) X[a + 1] += other; else carry = other; }
                }
                bf16x8 pk[4]; nsa_pack(pk, p0, p1);
                nsa_pv(o0, o1, NSA_VT, pk, lane);
                ++itc;
            }
#pragma unroll
            for (int a = 0; a < 8; ++a) imp[16 * jb + 2 * a + hi] = X[a];
        }
#pragma unroll
        for (int r = 0; r < 16; ++r) { oc0[r] = g0 * o0[r]; oc1[r] = g0 * o1[r]; }
    }
    __syncthreads();
    {
        LAS const float* impb = (LAS const float*)(lds + NS_IMP);
        LAS u64* maskl = (LAS u64*)(lds + NS_MASK);
#pragma unroll 1
        for (int q = 0; q < 8; ++q) {
            const int tok = F.wave * 8 + q, j = lane;
            const float v = ((impb[(0 * 64 + tok) * 64 + j] + impb[(1 * 64 + tok) * 64 + j]) + impb[(2 * 64 + tok) * 64 + j]) + impb[(3 * 64 + tok) * 64 + j];
            const bool vis = j <= i, forced = vis && ((j == 0) | (j == i) | (j == i - 1)), cand = vis && !forced;
            const int k = 16 - __builtin_popcountll(__ballot(forced)), ncand = __builtin_popcountll(__ballot(cand));
            const float vc = cand ? v : -INFINITY;
            u64 msk;
            if (ncand <= k) msk = __ballot(vis);
            else {
                float lo = 0.f, hi = 8.f, thr = 0.f;
                for (int itn = 0; itn < 64; ++itn) {
                    const float mid = 0.5f * (lo + hi);
                    if (!(mid > lo && mid < hi)) { thr = lo; break; }
                    const int c = __builtin_popcountll(__ballot(vc >= mid));
                    if (c == k) { thr = mid; break; }
                    if (c > k) lo = mid; else hi = mid;
                    thr = lo;
                }
                const int need = k - __builtin_popcountll(__ballot(vc > thr));
                const bool eq = vc == thr; const u64 meq = __ballot(eq);
                msk = __ballot(forced || (vc > thr) || (eq && mbcnt64(meq) < need));
            }
            if (lane == 0) maskl[tok] = msk;
        }
    }
    __syncthreads();
    const u64 mymask = ((LAS const u64*)(lds + NS_MASK))[32 * th + r32];
#pragma unroll
    for (int r = 0; r < 16; ++r) { accl[r * 64] = oc0[r]; accl[(16 + r) * 64] = oc1[r]; }
    {
        NsaSm ss{-1e30f, 0.f}; f32x16 o0, o1;
#pragma unroll
        for (int r = 0; r < 16; ++r) { o0[r] = 0.f; o1[r] = 0.f; }
        Ks = launder(KV) + ((size_t)(2 * NB * 4 + bg) * SEQ) * 64; Vs = Ks + ((size_t)NB * 4 * SEQ) * 64;
        NSA_LOAD(Ks, Vs, 0);
#ifndef NSA_SKIP_SEL
        for (int jb = 0; jb <= i; ++jb) {
            NSA_STAGE(); if (jb < i) NSA_LOAD(Ks, Vs, jb + 1);
            NSA_BAR();
            const bool att = (mymask >> jb) & 1ull;
            f32x16 p0, p1;
            const int dmin = tw0 - 64 * jb - 63;
            nsa_scores(p0, p1, NSA_KT, qr, 0.f, r32, hi);
            float cin = att ? b31 : -INFINITY;
            if (dmin < 113) { nsa_near(p0, p1, t - 64 * jb, 1, 1 << 30, lut, hi); cin = att ? 0.f : -INFINITY; }
            nsa_online(p0, p1, ss, o0, o1, NSA_VT, lane, cin);
            ++itc;
        }
#endif
        const float lt = xsum32(ss.l), f = lt > 0.f ? g1 / lt : 0.f;
#pragma unroll
        for (int r = 0; r < 16; ++r) { accl[r * 64] += f * o0[r]; accl[(16 + r) * 64] += f * o1[r]; }
    }
    {
        NsaSm sw{-1e30f, 0.f}; f32x16 o0, o1;
#pragma unroll
        for (int r = 0; r < 16; ++r) { o0[r] = 0.f; o1[r] = 0.f; }
#ifdef WIN_AS_CAUSAL
        const int j0 = 0;
#else
        const int j0 = max(i - 8, 0);
#endif
        Kw = launder(KV) + ((size_t)(4 * NB * 4 + bg) * SEQ) * 64; Vw = Kw + ((size_t)NB * 4 * SEQ) * 64;
        NSA_LOAD(Kw, Vw, j0);
#ifndef NSA_SKIP_WIN
        for (int jb = j0; jb <= i; ++jb) {
            NSA_STAGE(); if (jb < i) NSA_LOAD(Kw, Vw, jb + 1);
            NSA_BAR();
            f32x16 p0, p1;
            const int dmin = tw0 - 64 * jb - 63, dmax = tw0 + 31 - 64 * jb;
#ifdef WIN_AS_CAUSAL
            nsa_scores(p0, p1, NSA_KT, qr, 0.f, r32, hi);
            float cin = b31;
            if (dmin < 113) { nsa_near(p0, p1, t - 64 * jb, 1, 1 << 30, lut, hi); cin = 0.f; }
#else
            nsa_scores(p0, p1, NSA_KT, qr, 0.f, r32, hi);
            float cin = b31;
            if (!(dmin >= 113 && dmax < 512)) { nsa_near(p0, p1, t - 64 * jb, 1, 512, lut, hi); cin = 0.f; }
#endif
            nsa_online(p0, p1, sw, o0, o1, NSA_VT, lane, cin);
            ++itc;
        }
#endif
        const float lt = xsum32(sw.l), f = lt > 0.f ? g2 / lt : 0.f;
#pragma unroll
        for (int r = 0; r < 16; ++r) { o0[r] = accl[r * 64] + f * o0[r]; o1[r] = accl[(16 + r) * 64] + f * o1[r]; }
        bf16* op = ON + (size_t)(b * SEQ + t) * 2048 + h * 64 + 4 * hi;
#pragma unroll
        for (int a = 0; a < 4; ++a) {
            *(GAS unsigned long long*)(op + 8 * a) = (unsigned long long)pk2(o0[4 * a], o0[4 * a + 1]) | ((unsigned long long)pk2(o0[4 * a + 2], o0[4 * a + 3]) << 32);
            *(GAS unsigned long long*)(op + 32 + 8 * a) = (unsigned long long)pk2(o1[4 * a], o1[4 * a + 1]) | ((unsigned long long)pk2(o1[4 * a + 2], o1[4 * a + 3]) << 32);
        }
    }
#undef NSA_LOAD
#undef NSA_STAGE
#undef NSA_BAR
#undef NSA_KT
#undef NSA_VT
}

__device__ __forceinline__ unsigned f2sortable(float f) { const unsigned u = __builtin_bit_cast(unsigned, f); return u ^ ((u >> 31) ? 0xffffffffu : 0x80000000u); }

__device__ __forceinline__ void dsa_token(Frame& F, int b, int t, const bf16* QI, const bf16* KI, const float* WI, const bf16* CKVN, const bf16* QLAT, bf16* OLAT) {
    const int lane = F.lane, fr = lane & 15, fq = lane >> 4;
    const size_t row = (size_t)b * SEQ + t;
    LAS unsigned short* idxl = (LAS unsigned short*)(F.lds + IDXL_OFF + F.wave * 1024);
    LAS unsigned char* Cb = F.lds + RING_OFF + F.wave * 16384;
    LAS const float* lut = (LAS const float*)(F.lds + LUTD_OFF) + fr * 128;
    const int cmax = t >> 6;
    int nsel;
#ifndef REP_DSA_IDX
#define REP_DSA_IDX 1
#endif
#ifndef REP_DSA_ATT
#define REP_DSA_ATT 1
#endif
    for (int rep_i = 0; rep_i < REP_DSA_IDX; ++rep_i)
    {
        float sc[64];
        const bf16x8 qa = *(const GAS bf16x8*)(QI + row * 512 + fr * 32 + 8 * fq);
        const f32x4 w4 = *(const GAS f32x4*)(WI + row * 16 + 4 * fq);
        const GAS bf16* kp = (const GAS bf16*)(KI + ((size_t)b * SEQ + fr) * 32 + 8 * fq);
        bf16x8 kbuf[3][4];
        float vmax = -INFINITY, vmin = INFINITY;
#define DSA_KLOAD(c, ahead) do { _Pragma("unroll") for (int tau = 0; tau < 4; ++tau) kbuf[(c) % 3][tau] = *(const GAS bf16x8*)(kp + ((ahead) * 64 + 16 * tau) * 32); } while (0)
        const int cmax4 = cmax | 3;
        DSA_KLOAD(0, 0); DSA_KLOAD(1, 1);
#pragma unroll
        for (int c = 0; c < 64; ++c) sc[c] = -INFINITY;
#pragma unroll
        for (int g4 = 0; g4 < 16; ++g4) {
            if (4 * g4 <= cmax) {
#pragma unroll
                for (int c = 4 * g4; c < 4 * g4 + 4; ++c) {
                    asm volatile("" : "+v"(kp));
                    if (c + 2 < 64) { if (c + 2 <= cmax4) DSA_KLOAD(c + 2, 2); }
                    float v[4];
#pragma unroll
                    for (int tau = 0; tau < 4; ++tau) {
                        const f32x4 d = MFMA16(qa, kbuf[c % 3][tau], ((f32x4){0.f, 0.f, 0.f, 0.f}));
                        typedef int i32x4_ __attribute__((ext_vector_type(4)));
                        const f32x4 rl = __builtin_bit_cast(f32x4, __builtin_elementwise_max(__builtin_bit_cast(i32x4_, d), ((i32x4_){0, 0, 0, 0})));
                        v[tau] = fmaf(w4.w, rl[3], fmaf(w4.z, rl[2], fmaf(w4.y, rl[1], w4.x * rl[0])));
                    }
                    const SwapPair r0 = swap32p(v[0], v[2]), r1 = swap32p(v[1], v[3]);
                    const float a0 = __builtin_bit_cast(float, r0.a) + __builtin_bit_cast(float, r0.b), a1 = __builtin_bit_cast(float, r1.a) + __builtin_bit_cast(float, r1.b);
                    const SwapPair r2 = swap16p(a0, a1);
                    const float keep = __builtin_bit_cast(float, r2.a) + __builtin_bit_cast(float, r2.b);
                    const bool cand = 64 * c + lane <= t;
                    sc[c] = cand ? keep : -INFINITY; vmax = fmaxf(vmax, sc[c]); vmin = fminf(vmin, cand ? keep : INFINITY);
                    kp += 64 * 32;
                }
            }
        }
#undef DSA_KLOAD
        if (t < 256) {
            nsel = t + 1;
#pragma unroll
            for (int c = 0; c < 4; ++c) idxl[64 * c + lane] = (64 * c + lane <= t) ? (unsigned short)(64 * c + lane) : (unsigned short)0;
        } else {
            nsel = 256;
#define DSA_COUNT_L(OP, X, out) do { int cnt_ = 0; \
            _Pragma("unroll") for (int c = 0; c < 16; ++c) cnt_ += (sc[c] OP (X)) ? 1 : 0; \
            if (cmax >= 16) { _Pragma("unroll") for (int c = 16; c < 32; ++c) cnt_ += (sc[c] OP (X)) ? 1 : 0; } \
            if (cmax >= 32) { _Pragma("unroll") for (int c = 32; c < 48; ++c) cnt_ += (sc[c] OP (X)) ? 1 : 0; } \
            if (cmax >= 48) { _Pragma("unroll") for (int c = 48; c < 64; ++c) cnt_ += (sc[c] OP (X)) ? 1 : 0; } \
            out = cnt_; } while (0)
#define DSA_COUNT(OP, X, out) do { int l_; DSA_COUNT_L(OP, X, l_); out = wave_total_i(l_); } while (0)
            float lo = vmin, hi = vmax;
            lo = fminf(lo, swz<1>(lo)); lo = fminf(lo, swz<2>(lo)); lo = fminf(lo, swz<4>(lo)); lo = fminf(lo, swz<8>(lo)); lo = fminf(lo, swz<16>(lo)); { const SwapPair r = swap32(lo); lo = fminf(__builtin_bit_cast(float, r.a), __builtin_bit_cast(float, r.b)); }
            hi = fmaxf(hi, swz<1>(hi)); hi = fmaxf(hi, swz<2>(hi)); hi = fmaxf(hi, swz<4>(hi)); hi = fmaxf(hi, swz<8>(hi)); hi = fmaxf(hi, swz<16>(hi)); hi = xmax32(hi);
            float thr = lo; int c0; DSA_COUNT(>=, hi, c0);
            if (c0 >= 256) thr = hi;
            else {
                for (int itn = 0; itn < 64; ++itn) {
                    const float mid = lo + 0.5f * (hi - lo);
                    if (!(mid > lo && mid < hi)) { thr = lo; break; }
                    int cnt; DSA_COUNT(>=, mid, cnt);
                    if (cnt == 256) { thr = mid; break; }
                    if (cnt > 256) lo = mid; else hi = mid;
                    thr = lo;
                }
            }
            int nl; DSA_COUNT_L(>, thr, nl);
            const int cgt = wave_total_i(nl);
            const int need = 256 - cgt;
            if (need == 0) {
                int inc = nl;
                inc += __builtin_amdgcn_update_dpp(0, inc, 0x111, 0xf, 0xf, true);
                inc += __builtin_amdgcn_update_dpp(0, inc, 0x112, 0xf, 0xf, true);
                inc += __builtin_amdgcn_update_dpp(0, inc, 0x114, 0xf, 0xf, true);
                inc += __builtin_amdgcn_update_dpp(0, inc, 0x118, 0xf, 0xf, true);
                const int r0 = __builtin_amdgcn_readlane(inc, 15), r1 = r0 + __builtin_amdgcn_readlane(inc, 31), r2 = r1 + __builtin_amdgcn_readlane(inc, 47);
                int off = inc - nl + (fq == 0 ? 0 : fq == 1 ? r0 : fq == 2 ? r1 : r2);
                int key = lane; asm volatile("" : "+v"(key));
                const int dump = key + 256;
#pragma unroll
                for (int g4 = 0; g4 < 16; ++g4) {
                    if (4 * g4 <= cmax) {
#pragma unroll
                        for (int c = 4 * g4; c < 4 * g4 + 4; ++c) { const bool sel = sc[c] > thr;
                            idxl[sel ? off : dump] = (unsigned short)key; off += sel ? 1 : 0; key += 64; asm volatile("" : "+v"(key)); }
                    }
                }
            } else {
            int base = 0, eqb = 0;
#pragma unroll
            for (int g4 = 0; g4 < 16; ++g4) {
                if (4 * g4 <= cmax) {
#pragma unroll
                    for (int c = 4 * g4; c < 4 * g4 + 4; ++c) {
                        const bool eq = sc[c] == thr; const u64 meq = __ballot(eq);
                        const bool sel = (sc[c] > thr) || (eq && (eqb + mbcnt64(meq) < need));
                        const u64 ms = __ballot(sel);
                        if (sel) idxl[base + mbcnt64(ms)] = (unsigned short)(64 * c + lane);
                        base += __builtin_popcountll(ms); eqb += __builtin_popcountll(meq);
                    }
                }
            }
            }
#undef DSA_COUNT_L
#undef DSA_COUNT
        }
    }
    for (int rep_a = 0; rep_a < REP_DSA_ATT; ++rep_a) {
    bf16x8 qf[8];
    { const bf16* qp = QLAT + row * 4096 + fr * 256 + 8 * fq;
#pragma unroll
      for (int ks = 0; ks < 8; ++ks) qf[ks] = *(const GAS bf16x8*)(qp + 32 * ks); }
    f32x4 o[16];
#pragma unroll
    for (int ct = 0; ct < 16; ++ct) o[ct] = (f32x4){0.f, 0.f, 0.f, 0.f};
    float m = -1e30f, l = 0.f;
    const int nhc = (nsel + 15) >> 4;
    const GAS char* Cbase = (const GAS char*)(CKVN + (size_t)b * SEQ * 256) + fq * 16;
    bf16x8 crA[8], crB[8];
#define DSA_LOADT(cr, hc) do { const GAS char* src_ = Cbase + (size_t)idxl[16 * (hc) + fr] * 512; \
        _Pragma("unroll") for (int ks = 0; ks < 8; ++ks) cr[ks] = *(const GAS bf16x8*)(src_ + ks * 64); } while (0)
#define DSA_PV(pb_, rbase) do { \
        _Pragma("unroll") for (int cb = 0; cb < 2; ++cb) { s16x4 tf_[8];                      \
            _Pragma("unroll") for (int c8 = 0; c8 < 8; ++c8) tf_[c8] = __builtin_bit_cast(s16x4, __builtin_amdgcn_ds_read_tr16_b64_v4i16((LAS s16x4*)((rbase) + (8 * cb + c8) * 512))); \
            __builtin_amdgcn_sched_barrier(0); \
            _Pragma("unroll") for (int c8 = 0; c8 < 8; ++c8) o[8 * cb + c8] = __builtin_amdgcn_mfma_f32_16x16x16bf16_1k(tf_[c8], pb_, o[8 * cb + c8], 0, 0, 0); \
            __builtin_amdgcn_sched_barrier(0); } \
    } while (0)
#define DSA_PAIR(hc) do { \
        const bool two_ = (hc) + 1 < nhc; \
        const s16x4 iaA = *(LAS const s16x4*)(idxl + 16 * (hc) + 4 * fq), iaB = *(LAS const s16x4*)(idxl + 16 * (hc) + 16 + 4 * fq); \
        f32x4 s0 = {0.f, 0.f, 0.f, 0.f}, s1 = {0.f, 0.f, 0.f, 0.f}; \
        _Pragma("unroll") for (int ks = 0; ks < 8; ++ks) s0 = MFMA16(crA[ks], qf[ks], s0); \
        if (two_) { _Pragma("unroll") for (int ks = 0; ks < 8; ++ks) s1 = MFMA16(crB[ks], qf[ks], s1); } \
        _Pragma("unroll") for (int ks = 0; ks < 8; ++ks) *(LAS bf16x8*)(Cb + (4 * ks + fq) * 256 + fr * 16) = crA[ks]; \
        if (two_) { _Pragma("unroll") for (int ks = 0; ks < 8; ++ks) *(LAS bf16x8*)(Cb + 8192 + (4 * ks + fq) * 256 + fr * 16) = crB[ks]; } \
        if ((hc) + 2 < nhc) DSA_LOADT(crA, (hc) + 2); \
        if ((hc) + 3 < nhc) DSA_LOADT(crB, (hc) + 3); \
        float sv[8], bz[8]; \
        _Pragma("unroll") for (int r = 0; r < 4; ++r) { bz[r] = lut[min(max(t - (int)(unsigned short)iaA[r], 0), 127)]; bz[4 + r] = lut[min(max(t - (int)(unsigned short)iaB[r], 0), 127)]; } \
        _Pragma("unroll") for (int r = 0; r < 4; ++r) { const float va_ = s0[r] * QSCALE + bz[r], vb_ = s1[r] * QSCALE + bz[4 + r]; \
            sv[r] = (16 * (hc) + 4 * fq + r < nsel) ? va_ : -INFINITY; sv[4 + r] = (16 * (hc) + 16 + 4 * fq + r < nsel) ? vb_ : -INFINITY; } \
        float mx = fmaxf(fmaxf(fmaxf(sv[0], sv[1]), fmaxf(sv[2], sv[3])), fmaxf(fmaxf(sv[4], sv[5]), fmaxf(sv[6], sv[7]))); \
        mx = xmax16(mx); mx = xmax32(mx); \
        const float mn = fmaxf(m, mx), alpha = __builtin_amdgcn_exp2f(m - mn); m = mn; \
        float sum = 0.f; \
        _Pragma("unroll") for (int r = 0; r < 8; ++r) { sv[r] = __builtin_amdgcn_exp2f(sv[r] - mn); sum += sv[r]; } \
        l = l * alpha + sum; \
        if (__any(alpha != 1.0f)) { _Pragma("unroll") for (int ct = 0; ct < 16; ++ct) o[ct] = o[ct] * alpha; } \
        pg8::u32x2 pwA, pwB; pwA.x = cvtpk(sv[0], sv[1]); pwA.y = cvtpk(sv[2], sv[3]); pwB.x = cvtpk(sv[4], sv[5]); pwB.y = cvtpk(sv[6], sv[7]); \
        const s16x4 pbA = __builtin_bit_cast(s16x4, pwA), pbB = __builtin_bit_cast(s16x4, pwB); \
        DSA_PV(pbA, rb); \
        if (two_) DSA_PV(pbB, rb + 8192); \
    } while (0)
    LAS const unsigned char* rb = Cb + ((fr & 3) >> 1) * 256 + (4 * fq + (fr >> 2)) * 16 + (fr & 1) * 8;
    DSA_LOADT(crA, 0); if (nhc > 1) DSA_LOADT(crB, 1);
    for (int hc = 0; hc < nhc; hc += 2) DSA_PAIR(hc);
#undef DSA_PAIR
#undef DSA_PV
#undef DSA_LOADT
    const float lt = xsum16(l); const float ltt = xsum32(lt); const float inv = ltt > 0.f ? 1.0f / ltt : 0.f;
    asm volatile("s_waitcnt lgkmcnt(0)" ::: "memory");
    bf16* op = OLAT + row * 4096 + fr * 256 + 4 * fq;
#pragma unroll
    for (int ct = 0; ct < 16; ++ct) *(GAS unsigned long long*)(op + 16 * ct) = (unsigned long long)pk2(o[ct][0] * inv, o[ct][1] * inv) | ((unsigned long long)pk2(o[ct][2] * inv, o[ct][3] * inv) << 32);
    }
}

__device__ __forceinline__ void p0_prologue(Frame& F, const Args& a) {
    unsigned char* ws = a.ws;
    {
        LAS float* cact = (LAS float*)(F.lds + RING_OFF);
        LAS float* red = (LAS float*)(F.lds + RING_OFF + 32768);
        const float* c = a.in[1];
        for (int i = F.tid; i < NB * D; i += NWAVES * 64) cact[i] = silu_f(c[i]);
        __syncthreads();
        float* MOD = (float*)(ws + WS_MOD);
        const int cg = F.tid & 7, kg = F.tid >> 3;
        constexpr int NIT = DEPTH * (NMOD / 32);
        for (int it = F.vcu; it < NIT; it += F.G) {
            const int l = it / (NMOD / 32), j0 = (it % (NMOD / 32)) * 32;
            const float* W = a.in[2] + (size_t)l * D * NMOD + j0 + 4 * cg;
            f32x4 acc[4] = {{0.f, 0.f, 0.f, 0.f}, {0.f, 0.f, 0.f, 0.f}, {0.f, 0.f, 0.f, 0.f}, {0.f, 0.f, 0.f, 0.f}};
#pragma unroll 16
            for (int kk = 0; kk < 32; ++kk) { const int k = kg * 32 + kk; const f32x4 w = *(const GAS f32x4*)(W + (size_t)k * NMOD);
#pragma unroll
                for (int b = 0; b < 4; ++b) acc[b] += w * cact[b * D + k]; }
#pragma unroll
            for (int b = 0; b < 4; ++b) *(LAS f32x4*)(red + (kg * 4 + b) * 32 + 4 * cg) = acc[b];
            __syncthreads();
            if (F.tid < 128) { const int b = F.tid >> 5, col = F.tid & 31; float sm = 0.f;
#pragma unroll 16
              for (int q = 0; q < 64; ++q) sm += red[(q * 4 + b) * 32 + col];
              MOD[((size_t)l * NB + b) * NMOD + j0 + col] = sm + a.in[3][(size_t)l * NMOD + j0 + col]; }
            __syncthreads();
        }
    }
    LAS float* scr = (LAS float*)(F.lds + RING_OFF + F.wave * 16384);
    const int gw = F.vcu * NWAVES + F.wave, NGW = F.G * NWAVES;
    constexpr int I_FI = (D / 64) * (2 * FF / 32), I_FO = (FF / 64) * (D / 32), I_WIN = (D / 64) * (NIN / 32), I_UP = (1024 / 64) * (D / 32), I_WO = (D / 64) * (D / 32);
    constexpr int PER_L = 2 * I_FI + 2 * I_FO + I_WIN + 2 * I_UP + I_WO;
    for (int it = gw; it < DEPTH * PER_L; it += NGW) {
        const int l = it / PER_L; int r = it % PER_L;
        if (r < 2 * I_FI) { const int f = r / I_FI; p0_transpose_item(a.in[5] + ((size_t)l * 2 + f) * D * 2 * FF, D, 2 * FF, (bf16*)(ws + WS_WFI + ((size_t)l * 2 + f) * SZ_WFI1), MapFfnIn(), scr, r % I_FI, F.lane); continue; } r -= 2 * I_FI;
        if (r < 2 * I_FO) { const int f = r / I_FO; p0_transpose_item(a.in[6] + ((size_t)l * 2 + f) * FF * D, FF, D, (bf16*)(ws + WS_WFO + ((size_t)l * 2 + f) * SZ_WFO1), MapIdent(), scr, r % I_FO, F.lane); continue; } r -= 2 * I_FO;
        if (r < I_WIN) { p0_transpose_item(a.in[7] + (size_t)l * D * NIN, D, NIN, (bf16*)(ws + WS_WIN + (size_t)l * SZ_WIN1), MapWin(), scr, r, F.lane); continue; } r -= I_WIN;
        if (r < I_UP) { p0_transpose_item(a.in[17] + (size_t)l * 1024 * D, 1024, D, (bf16*)(ws + WS_WUPN + (size_t)l * 2 * SZ_WUP1), MapIdent(), scr, r, F.lane, 2048, 0); continue; } r -= I_UP;
        if (r < I_UP) { p0_transpose_item(a.in[18] + (size_t)l * 1024 * D, 1024, D, (bf16*)(ws + WS_WUPN + (size_t)l * 2 * SZ_WUP1), MapIdent(), scr, r, F.lane, 2048, 1024); continue; } r -= I_UP;
        p0_transpose_item(a.in[19] + (size_t)l * D * D, D, D, (bf16*)(ws + WS_WOUT + (size_t)l * SZ_WOUT1), MapIdent(), scr, r, F.lane);
    }
    for (int l = 0; l < DEPTH; ++l) { GAS v4u* p = (GAS v4u*)(ws + WS_WIN + (size_t)l * SZ_WIN1 + (size_t)4448 * D * 2);
        for (int i = gw * 64 + F.lane; i < 160 * D * 2 / 16; i += NGW * 64) p[i] = (v4u){0u, 0u, 0u, 0u}; }
    { constexpr int I_C1 = (2048 / 64) * (256 / 32), I_C2 = (256 / 64) * (64 / 32), I_UV = (256 / 64) * (1024 / 32), PER = 2 * I_C1 + 2 * I_C2 + I_UV;
      for (int it = gw; it < DEPTH * PER; it += NGW) { const int l = it / PER; int r = it % PER;
        if (r < 2 * I_C1) { const int kv = r / I_C1; p0_transpose_item(a.in[kv ? 12 : 10] + (size_t)l * 2048 * 256, 2048, 256, (bf16*)(ws + WS_WC1) + ((size_t)l * 512 + kv * 256) * 2048, MapIdent(), scr, r % I_C1, F.lane); continue; } r -= 2 * I_C1;
        if (r < 2 * I_C2) { const int kv = r / I_C2; p0_transpose_item(a.in[kv ? 13 : 11] + (size_t)l * 256 * 64, 256, 64, (bf16*)(ws + WS_WC2) + ((size_t)l * 2 + kv) * 64 * 256, MapIdent(), scr, r % I_C2, F.lane); continue; } r -= 2 * I_C2;
        p0_transpose_item(a.in[16] + (size_t)l * 256 * 1024, 256, 1024, (bf16*)(ws + WS_WUVT) + (size_t)l * 1024 * 256, MapIdent(), scr, r, F.lane); } }
    { const float* src = a.in[15]; bf16* dst = (bf16*)(ws + WS_WUK);
      for (int i = gw * 64 + F.lane; i < DEPTH * 256 * 1024 / 4; i += NGW * 64) { const f32x4 v = *(const GAS f32x4*)(src + 4 * (size_t)i);
          *(GAS unsigned long long*)(dst + 4 * (size_t)i) = (unsigned long long)pk2(v.x, v.y) | ((unsigned long long)pk2(v.z, v.w) << 32); } }
    for (int it = gw; it < DEPTH * 2 * 4; it += NGW) { const int l = it >> 3, kv = (it >> 2) & 1, j = (it & 3) * 64 + F.lane;
        const float* pe = a.in[kv ? 9 : 8] + (size_t)l * 2048; const float* w1 = a.in[kv ? 12 : 10] + (size_t)l * 2048 * 256 + j; float s = 0.f;
        for (int k = 0; k < 2048; ++k) s += pe[k] * w1[(size_t)k * 256];
        ((float*)(ws + WS_B1))[(l * 2 + kv) * 256 + j] = s; }
}

__global__ void __launch_bounds__(NWAVES * 64, 2) mk_fwd(Args args) {
    extern __shared__ __attribute__((aligned(16))) unsigned char lds[];
    Frame F;
    F.lds = (LAS unsigned char*)lds;
    F.MISC = (volatile LAS unsigned*)(F.lds + MISC_OFF);
    F.tid = threadIdx.x; F.lane = F.tid & 63; F.wave = __builtin_amdgcn_readfirstlane(F.tid >> 6);
    F.G = gridDim.x; { const int bx = blockIdx.x; F.vcu = (F.G % 8 == 0) ? (bx % 8) * (F.G / 8) + bx / 8 : bx; }
    unsigned char* ws = args.ws;
    F.ctl = (gu32*)(ws + WS_CTL);
    for (int u = F.tid; u < (LDS_BYTES - LDSCTL_OFF) / 4; u += NWAVES * 64) ((LAS unsigned*)(F.lds + LDSCTL_OFF))[u] = 0u;
    __syncthreads();
    XcdBarrier bar = xcd_barrier_post((unsigned*)(F.ctl + CW_BAR) + args.li * XCD_BAR_WORDS, F.MISC + 8);
    const int lo = args.ph_lo, hi = args.ph_hi;
#define IN(k) (lo <= (k) && (k) < hi)
#define SEAM(k) do { if ((k) + 1 < hi) xcd_barrier(bar, F.wave); } while (0)

    if (IN(0)) { for (int rep = 0; rep < REP_P0; ++rep) { p0_prologue(F, args); if (rep + 1 < REP_P0) __syncthreads(); } SEAM(0); }

    for (int ll = 0; ll < DEPTH * REP_ALL; ++ll) { const int l = ll % DEPTH;
        const int pb = 1 + l * NPL;
        if (PHON(0) && IN(pb + 0)) { unsigned char* w = launder(ws); Frame Fp = refresh(F); const float* xin0 = (l == 0) ? launder(args.in[0]) : (const float*)(w + WS_X);
            for (int rep = 0; rep < REP_MOD; ++rep) modulate_phase(Fp, xin0, (bf16*)(w + WS_H), launder(args.in[4]) + (size_t)l * 3 * D, (const float*)(w + WS_MOD) + (size_t)l * NB * NMOD); SEAM(pb + 0); }
        if (PHON(1) && IN(pb + 1)) { unsigned char* w = launder(ws); Frame Fp = refresh(F);
            pg8::Gemm g{(const bf16*)(w + WS_H), (const bf16*)(w + WS_WFI + ((size_t)l * 2 + 0) * SZ_WFI1), M, 2 * FF, D, D, D}; pg8::StaticOrder S; S.init(M, 2 * FF, Fp.G, (int)blockIdx.x);
            EpiSwiglu E{(bf16*)(w + WS_ACT)};
            for (int rep = 0; rep < REP_FFI; ++rep) pg8::gemm_phase<EpiSwiglu, pg8::StaticOrder, true, true>(Fp.lds + RING_OFF, g, S, E, Fp.wave);
            SEAM(pb + 1);
        }
        if (PHON(2) && IN(pb + 2)) { unsigned char* w = launder(ws); Frame Fp = refresh(F); const float* xin0 = (l == 0) ? launder(args.in[0]) : (const float*)(w + WS_X);
            pg8::Gemm g{(const bf16*)(w + WS_ACT), (const bf16*)(w + WS_WFO + ((size_t)l * 2 + 0) * SZ_WFO1), M, D, FF, FF, FF}; pg8::StaticOrder S; S.init(M, D, Fp.G, (int)blockIdx.x);
            EpiResid E{xin0, (float*)(w + WS_X), (const float*)(w + WS_MOD) + (size_t)l * NB * NMOD + 2 * D, 0.5f};
            for (int rep = 0; rep < (l == 0 ? REP_FFO : 1); ++rep) pg8::gemm_phase<EpiResid, pg8::StaticOrder, true, true>(Fp.lds + RING_OFF, g, S, E, Fp.wave);
            SEAM(pb + 2);
        }
        if (PHON(3) && IN(pb + 3)) { unsigned char* w = launder(ws); Frame Fp = refresh(F);
            for (int rep = 0; rep < REP_MOD; ++rep) modulate_phase(Fp, (const float*)(w + WS_X), (bf16*)(w + WS_H), launder(args.in[4]) + (size_t)l * 3 * D + D, (const float*)(w + WS_MOD) + (size_t)l * NB * NMOD + 3 * D); SEAM(pb + 3); }
        if (PHON(4) && IN(pb + 4)) { unsigned char* w = launder(ws); Frame Fp = refresh(F);
            pg8::Gemm g{(const bf16*)(w + WS_H), (const bf16*)(w + WS_WIN + (size_t)l * SZ_WIN1), M, NINP, D, D, D}; pg8::StaticOrder S; S.init(M, NINP, Fp.G, (int)blockIdx.x);
            EpiWin E{w};
            for (int rep = 0; rep < REP_WIN; ++rep) pg8::gemm_phase<EpiWin, pg8::StaticOrder, true, true>(Fp.lds + RING_OFF, g, S, E, Fp.wave);
            SEAM(pb + 4);
        }
        if (PHON(5) && IN(pb + 5)) { unsigned char* w = launder(ws); Frame Fp = refresh(F);
            const int ncmp = Fp.G > 64 ? 32 : 0;
            const bool spread = (Fp.G == 256);
            const bool iscmp = ncmp == 0 || (spread ? (Fp.vcu & 31) < 4 : Fp.vcu < ncmp);
            const int crank = spread ? (Fp.vcu >> 5) * 4 + (Fp.vcu & 31) : Fp.vcu;
            const int trank = spread ? (Fp.vcu >> 5) * 28 + (Fp.vcu & 31) - 4 : Fp.vcu - ncmp;
            if (iscmp) {
                pg8::Gemm g{(const bf16*)(w + WS_KV), (const bf16*)(w + WS_WC1 + (size_t)l * 512 * 2048 * 2), 8192, 512, 2048, 1024, 2048}; CmpOrder S{ncmp ? ncmp : Fp.G, ncmp ? crank : Fp.vcu};
                EpiCmp1 E{(bf16*)(w + WS_CMPH), (const float*)(w + WS_B1) + l * 512};
                pg8::gemm_phase<EpiCmp1, CmpOrder, true, true>(Fp.lds + RING_OFF, g, S, E, Fp.wave);
                if (ncmp) cmp2_items((const bf16*)(w + WS_CMPH), (const bf16*)(w + WS_WC2) + (size_t)l * 2 * 64 * 256, (bf16*)(w + WS_KCMP), crank * 16, crank * 16 + 16, Fp.wave, NWAVES, Fp.lane);
            }
            if (ncmp == 0 || !iscmp) { const int tr_ = ncmp ? trank : Fp.vcu; const int w0 = tr_ * NWAVES + Fp.wave, nw = (Fp.G - ncmp) * NWAVES;
                for (int rep = 0; rep < REP_THIN; ++rep) ckvnorm_rows((const float*)(w + WS_CKVR), (bf16*)(w + WS_CKVN), launder(args.in[14]) + l * 256, w0, nw, Fp.lane);
                for (int rep = 0; rep < REP_THIN; ++rep) qlat_items((const bf16*)(w + WS_QD), (const bf16*)(w + WS_WUK) + (size_t)l * 256 * 1024, (bf16*)(w + WS_QLAT), tr_ >> 1, (Fp.G - ncmp) >> 1, tr_ & 1, Fp.wave, Fp.lane); }
            SEAM(pb + 5);
        }
        if (PHON(6) && IN(pb + 6) && !(F.G > 64)) { unsigned char* w = launder(ws); Frame Fp = refresh(F);
            for (int kvh = 0; kvh < 2; ++kvh) cmp2_items((const bf16*)(w + WS_CMPH), (const bf16*)(w + WS_WC2) + (size_t)l * 2 * 64 * 256, (bf16*)(w + WS_KCMP), 256 * kvh, 256 * kvh + 256, Fp.vcu * NWAVES + Fp.wave, Fp.G * NWAVES, Fp.lane);
            SEAM(pb + 6);
        }
        if (PHON(7) && IN(pb + 7)) { unsigned char* w = launder(ws); Frame Fp = refresh(F);
            build_luts(Fp, launder(args.in[20]));
            if (Fp.G == 256) {
                const int b = Fp.vcu >> 6, g = (Fp.vcu >> 4) & 3, s = Fp.vcu & 15; int itc = 0;
#pragma unroll 1
                for (int qq = 0; qq < 4 * REP_NSA; ++qq) { const int q = qq & 3; const int i = (q == 0) ? s : (q == 1) ? 31 - s : (q == 2) ? 32 + s : 63 - s;
#ifndef NO_NSA
                    nsa_unit(Fp, b, g, i, (const bf16*)(w + WS_QN), (const bf16*)(w + WS_KV), (const bf16*)(w + WS_KCMP), (const float*)(w + WS_GN), (bf16*)(w + WS_ON), itc);
#endif
                }
                __syncthreads();
                const int j = (Fp.vcu & 63) * NWAVES + Fp.wave;
#pragma unroll 1
                for (int kk = 0; kk < 8 * REP_DSA; ++kk) { const int k = (Fp.wave & 4) ? 7 - (kk & 7) : (kk & 7); const int t = 512 * k + ((k & 1) ? 511 - j : j);
#ifndef NO_DSA
                    dsa_token(Fp, b, t, (const bf16*)(w + WS_QI), (const bf16*)(w + WS_KI), (const float*)(w + WS_WI), (const bf16*)(w + WS_CKVN), (const bf16*)(w + WS_QLAT), (bf16*)(w + WS_OLAT));
#endif
                }
            }
            SEAM(pb + 7);
        }
        if (PHON(8) && IN(pb + 8)) { unsigned char* w = launder(ws); Frame Fp = refresh(F);
            for (int rep = 0; rep < REP_THIN; ++rep) od_items((const bf16*)(w + WS_OLAT), (const bf16*)(w + WS_WUVT) + (size_t)l * 1024 * 256, (bf16*)(w + WS_ON), Fp.vcu, Fp.G, Fp.wave, Fp.lane);
            SEAM(pb + 8);
        }
        if (PHON(9) && IN(pb + 9)) { unsigned char* w = launder(ws); Frame Fp = refresh(F);
            pg8::Gemm g{(const bf16*)(w + WS_ON), (const bf16*)(w + WS_WUPN + (size_t)l * 2 * SZ_WUP1), M, D, 2048, 2048, 2048}; pg8::StaticOrder S; S.init(M, D, Fp.G, (int)blockIdx.x);
            EpiUpF E{(const bf16*)(w + WS_AM), (bf16*)(w + WS_Y)};
            pg8::gemm_phase<EpiUpF, pg8::StaticOrder, true, true>(Fp.lds + RING_OFF, g, S, E, Fp.wave);
            SEAM(pb + 9);
        }
        if (PHON(10) && IN(pb + 10)) { unsigned char* w = launder(ws); Frame Fp = refresh(F);
            pg8::Gemm g{(const bf16*)(w + WS_Y), (const bf16*)(w + WS_WOUT + (size_t)l * SZ_WOUT1), M, D, D, D, D}; pg8::StaticOrder S; S.init(M, D, Fp.G, (int)blockIdx.x);
            EpiResid E{(const float*)(w + WS_X), (float*)(w + WS_X), (const float*)(w + WS_MOD) + (size_t)l * NB * NMOD + 3 * D + 2 * D, 1.0f};
            pg8::gemm_phase<EpiResid, pg8::StaticOrder, true, true>(Fp.lds + RING_OFF, g, S, E, Fp.wave);
            SEAM(pb + 10);
        }
        if (PHON(11) && IN(pb + 11)) { unsigned char* w = launder(ws); Frame Fp = refresh(F);
            for (int rep = 0; rep < REP_MOD; ++rep) modulate_phase(Fp, (const float*)(w + WS_X), (bf16*)(w + WS_H), launder(args.in[4]) + (size_t)l * 3 * D + 2 * D, (const float*)(w + WS_MOD) + (size_t)l * NB * NMOD + 2 * 3 * D); SEAM(pb + 11); }
        if (PHON(12) && IN(pb + 12)) { unsigned char* w = launder(ws); Frame Fp = refresh(F);
            pg8::Gemm g{(const bf16*)(w + WS_H), (const bf16*)(w + WS_WFI + ((size_t)l * 2 + 1) * SZ_WFI1), M, 2 * FF, D, D, D}; pg8::StaticOrder S; S.init(M, 2 * FF, Fp.G, (int)blockIdx.x);
            EpiSwiglu E{(bf16*)(w + WS_ACT)};
            for (int rep = 0; rep < REP_FFI; ++rep) pg8::gemm_phase<EpiSwiglu, pg8::StaticOrder, true, true>(Fp.lds + RING_OFF, g, S, E, Fp.wave);
            SEAM(pb + 12);
        }
        if (PHON(13) && IN(pb + 13)) { unsigned char* w = launder(ws); Frame Fp = refresh(F);
            pg8::Gemm g{(const bf16*)(w + WS_ACT), (const bf16*)(w + WS_WFO + ((size_t)l * 2 + 1) * SZ_WFO1), M, D, FF, FF, FF}; pg8::StaticOrder S; S.init(M, D, Fp.G, (int)blockIdx.x);
            EpiResid E{(const float*)(w + WS_X), (float*)(w + WS_X), (const float*)(w + WS_MOD) + (size_t)l * NB * NMOD + 2 * 3 * D + 2 * D, 0.5f};
            pg8::gemm_phase<EpiResid, pg8::StaticOrder, true, true>(Fp.lds + RING_OFF, g, S, E, Fp.wave);
            SEAM(pb + 13);
        }
    }
    if (IN(NPH - 1)) { unsigned char* w = launder(ws); Frame Fp = refresh(F); final_norm_phase(Fp, (const float*)(w + WS_X), launder(args.out), launder(args.in[21])); }
#undef IN
#undef SEAM
}

extern "C" void kernel_launch(void* const* d_in, const int* in_sizes, int n_in, void* d_out, int out_size, void* d_ws, size_t ws_size, hipStream_t stream) {
    static int grid = 0;
    if (grid == 0) {
        if (n_in != 22 || out_size != M * D || ws_size < WS_END) { fprintf(stderr, "kernel_launch: unexpected shapes (n_in %d, out %d, ws %zu < %zu)\n", n_in, out_size, ws_size, (size_t)WS_END); grid = -1; return; }
        int dev = 0, cus = 0, per_cu = 0;
        if (hipGetDevice(&dev) != hipSuccess || hipDeviceGetAttribute(&cus, hipDeviceAttributeMultiprocessorCount, dev) != hipSuccess) { grid = -1; return; }
        if (hipFuncSetAttribute((const void*)mk_fwd, hipFuncAttributeMaxDynamicSharedMemorySize, LDS_BYTES) != hipSuccess) { fprintf(stderr, "kernel_launch: hipFuncSetAttribute failed\n"); grid = -1; return; }
        if (hipOccupancyMaxActiveBlocksPerMultiprocessor(&per_cu, (const void*)mk_fwd, NWAVES * 64, LDS_BYTES) != hipSuccess || per_cu < 1) fprintf(stderr, "kernel_launch: occupancy query says %d\n", per_cu);
        (void)hipGetLastError();
        grid = cus;
    }
    if (grid < 0) return;
    (void)hipMemsetAsync((char*)d_ws + WS_CTL, 0, CTL_ZERO_BYTES, stream);
    Args a{};
    for (int i = 0; i < 22; ++i) a.in[i] = (const float*)d_in[i];
    a.out = (float*)d_out; a.ws = (unsigned char*)d_ws;
    a.ph_lo = 0; a.ph_hi = NPH; a.li = 0; a.pad = 0;
    hipLaunchKernelGGL(mk_fwd, dim3(grid), dim3(NWAVES * 64), LDS_BYTES, stream, a);
}
```

```cpp
#include <hip/hip_runtime.h>
#include <cstdio>
#include <cstdint>


#ifndef PHM
#define PHM 0xffff
#endif
#define PHON(k) (((PHM) >> (k)) & 1)
#ifndef REP_P0
#define REP_P0 1
#endif
#ifndef REP_FFI
#define REP_FFI 1
#endif
#ifndef REP_FFO
#define REP_FFO 1
#endif
#ifndef REP_WIN
#define REP_WIN 1
#endif
#ifndef REP_UP
#define REP_UP 1
#endif
#ifndef REP_MOD
#define REP_MOD 1
#endif
#ifndef REP_THIN
#define REP_THIN 1
#endif
#ifndef REP_ALL
#define REP_ALL 1
#endif
#ifndef REP_NSA
#define REP_NSA 1
#endif
#ifndef REP_DSA
#define REP_DSA 1
#endif

__device__ __forceinline__ int fresh_lane() { unsigned z = 0u; asm volatile("" : "+v"(z)); return (int)__builtin_amdgcn_mbcnt_hi(~0u, __builtin_amdgcn_mbcnt_lo(~0u, z)); }

namespace pg8 {
#define PG8_LAS __attribute__((address_space(3)))
typedef unsigned short bf16_t;
typedef short bf16x8 __attribute__((ext_vector_type(8)));
typedef float f32x4 __attribute__((ext_vector_type(4)));
typedef float f32x2 __attribute__((ext_vector_type(2)));
typedef unsigned u32x4 __attribute__((ext_vector_type(4)));
typedef unsigned u32x2 __attribute__((ext_vector_type(2)));
constexpr int BM = 256, BK = 64, HALF = 128, HTB = HALF * BK * 2, STAGE_BYTES = 8 * HTB, NXCD = 8, WGM = 8;

__host__ __device__ __forceinline__ int lds_byte(int r, int c) { const int st = (r >> 4) * 2 + (c >> 5), rr = r & 15, cc = c & 31, ob = rr * 64 + cc * 2; return st * 1024 + (ob ^ (((ob >> 9) & 1) << 5)); }
__host__ __device__ __forceinline__ void stage_rc(int b, int& R, int& C) { const int st = b / 1024, sb = b % 1024, swz = sb ^ (((sb >> 9) & 1) << 5); R = (st >> 1) * 16 + swz / 64; C = (st & 1) * 32 + (swz % 64) / 2; }
__host__ __device__ __forceinline__ int perm32(int rho) { const int n = rho >> 4, i = rho & 15; return 8 * (i >> 2) + 4 * n + (i & 3); }

struct Unit { int pm, pn; };
struct Gemm { const bf16_t* A; const bf16_t* Bt; int M, N, K, lda, ldb; };

struct StaticOrder {
    int nM, nN, nwg, G, c;
    __host__ __device__ void init(int M, int N, int G_, int c_) { nM = M / BM; nN = N / BM; nwg = nM * nN; G = G_; c = c_; }
    __host__ __device__ bool next(int i, Unit& u) const {
        const long L = (long)i * G + c; if (L >= nwg) return false;
        int wgid = (int)L; { const int q = nwg / NXCD, r = nwg % NXCD, xcd = wgid % NXCD, off = wgid / NXCD; wgid = (xcd < r ? xcd * (q + 1) : r * (q + 1) + (xcd - r) * q) + off; }
        const int nig = WGM * nN, gid = wgid / nig, fm = gid * WGM, gsz = (nM - fm) < WGM ? (nM - fm) : WGM;
        u.pm = fm + ((wgid % nig) % gsz); u.pn = (wgid % nig) / gsz; return true;
    }
    __device__ __forceinline__ void a_ready(const Unit&) const {}
    __device__ __forceinline__ void done(const Unit&) const {}
};

typedef __bf16 pk_bf2_t __attribute__((ext_vector_type(2)));
typedef float pk_f2_t __attribute__((ext_vector_type(2)));
__device__ __forceinline__ unsigned cvt_pk_bf16(float lo, float hi) { const pk_f2_t v = {lo, hi}; return __builtin_bit_cast(unsigned, __builtin_convertvector(v, pk_bf2_t)); }

template <class Epi, class Sched, bool ALIGN_EPI = false, bool SP2 = false>
__device__ __forceinline__ void gemm_phase(PG8_LAS unsigned char* lds, const Gemm g, const Sched& S, const Epi& E, int wave_s) {
    int tid_ = (wave_s << 6) | fresh_lane(); asm volatile("" : "+v"(tid_));
    const int tid = tid_, wid = __builtin_amdgcn_readfirstlane(tid >> 6), lane = tid & 63, wr = wid >> 2, wc = wid & 3, fr = lane & 15, fq = lane >> 4;
    const int K = g.K, nt = K / BK;
    unsigned voffA[2], voffB[2];
#pragma unroll
    for (int i = 0; i < 2; ++i) { int R, C; stage_rc(tid * 16 + i * 8192, R, C); const int Rb = Epi::PERM ? ((R & ~31) + perm32(R & 31)) : R;
        voffA[i] = (unsigned)(R * g.lda + C) * 2u; voffB[i] = (unsigned)(Rb * g.ldb + C) * 2u; }
    const size_t kstep = (size_t)(BK * 2);
    const size_t hstepA = (size_t)HALF * g.lda * 2, hstepB = (size_t)HALF * g.ldb * 2;
    const size_t tstepA = 2 * hstepA, tstepB = 2 * hstepB;
    const unsigned ldsw = (unsigned)wid * 1024u;
    const int aoff = lds_byte(wr * 64 + fr, fq * 8), boff = lds_byte(wc * 32 + fr, fq * 8);
#define PG8_SA(b, h) (((b) * 2 + (h)) * HTB)
#define PG8_SB(b, h) ((4 + (b) * 2 + (h)) * HTB)
#define PG8_STAGE(bufoff, gbase, voff) do { _Pragma("unroll") for (int _i = 0; _i < 2; ++_i) \
        __builtin_amdgcn_global_load_lds((const unsigned*)((const char*)(gbase) + (voff)[_i]), (PG8_LAS unsigned*)(lds + (bufoff) + ldsw + _i * 8192), 16, 0, 0); } while (0)
#define PG8_LDA(dst, b, h) do { _Pragma("unroll") for (int m = 0; m < 4; ++m) _Pragma("unroll") for (int k = 0; k < 2; ++k) dst[m][k] = *(const PG8_LAS bf16x8*)(lds + PG8_SA(b, h) + aoff + m * 2048 + k * 1024); } while (0)
#define PG8_LDB(dst, b, h) do { _Pragma("unroll") for (int n = 0; n < 2; ++n) _Pragma("unroll") for (int k = 0; k < 2; ++k) dst[n][k] = *(const PG8_LAS bf16x8*)(lds + PG8_SB(b, h) + boff + n * 2048 + k * 1024); } while (0)
#define PG8_MMA(ai, bj, At, Bt) do { __builtin_amdgcn_s_setprio(1); _Pragma("unroll") for (int m = 0; m < 4; ++m) _Pragma("unroll") for (int n = 0; n < 2; ++n) _Pragma("unroll") for (int k = 0; k < 2; ++k) \
        acc[ai][bj][m][n] = __builtin_amdgcn_mfma_f32_16x16x32_bf16(Bt[n][k], At[m][k], acc[ai][bj][m][n], 0, 0, 0); __builtin_amdgcn_s_setprio(0); } while (0)
#define PG8_WAIT_V(n) asm volatile("s_waitcnt vmcnt(" #n ")" ::: "memory")
#define PG8_WAIT_L(n) asm volatile("s_waitcnt lgkmcnt(" #n ")" ::: "memory")
#define PG8_BAR __builtin_amdgcn_s_barrier()
#define PG8_SCHED __builtin_amdgcn_sched_barrier(0)
    Unit cur, nxt; int ui = 0;
    if (!S.next(0, cur)) return;
    f32x4 acc[2][2][4][2];
#pragma unroll
    for (int a = 0; a < 2; ++a)
#pragma unroll
        for (int b = 0; b < 2; ++b)
#pragma unroll
            for (int m = 0; m < 4; ++m)
#pragma unroll
                for (int n = 0; n < 2; ++n) acc[a][b][m][n] = (f32x4){0.f, 0.f, 0.f, 0.f};
    bf16x8 At[4][2], B0[2][2], B1[2][2];
    const char* cA = (const char*)g.A + (size_t)cur.pm * tstepA; const char* cB = (const char*)g.Bt + (size_t)cur.pn * tstepB;
    S.a_ready(cur);
    if constexpr (SP2) {
        PG8_STAGE(PG8_SB(0, 0), cB, voffB); PG8_STAGE(PG8_SB(0, 1), cB + hstepB, voffB); PG8_STAGE(PG8_SA(0, 0), cA, voffA); PG8_STAGE(PG8_SA(0, 1), cA + hstepA, voffA);
        if (wr == 1) PG8_BAR;
        PG8_WAIT_V(2); PG8_BAR;
        PG8_STAGE(PG8_SB(1, 0), cB + kstep, voffB); PG8_STAGE(PG8_SA(1, 0), cA + kstep, voffA); PG8_STAGE(PG8_SB(1, 1), cB + hstepB + kstep, voffB);
        PG8_WAIT_V(6); PG8_BAR;
    } else {
        PG8_STAGE(PG8_SB(0, 0), cB, voffB); PG8_STAGE(PG8_SA(0, 0), cA, voffA); PG8_STAGE(PG8_SB(0, 1), cB + hstepB, voffB); PG8_STAGE(PG8_SA(0, 1), cA + hstepA, voffA);
        if (wr == 1) PG8_BAR;
        PG8_WAIT_V(4); PG8_BAR;
        PG8_STAGE(PG8_SB(1, 0), cB + kstep, voffB); PG8_STAGE(PG8_SA(1, 0), cA + kstep, voffA); PG8_STAGE(PG8_SB(1, 1), cB + hstepB + kstep, voffB);
        PG8_WAIT_V(6); PG8_BAR;
    }
    for (;;) {
        const bool has_next = S.next(ui + 1, nxt);
        const char* nA = has_next ? (const char*)g.A + (size_t)nxt.pm * tstepA : cA; const char* nB = has_next ? (const char*)g.Bt + (size_t)nxt.pn * tstepB : cB;
        for (int t = 0; t < nt; t += 2) {
            const bool last = (t == nt - 2);
            const char* a1 = cA + (size_t)(t + 1) * kstep;
            const char* a2 = last ? nA : cA + (size_t)(t + 2) * kstep; const char* b2 = last ? nB : cB + (size_t)(t + 2) * kstep;
            const char* a3 = a2 + kstep; const char* b3 = b2 + kstep;
            if (last && has_next) S.a_ready(nxt);
            if constexpr (Epi::HAS_MID) { if (t == nt / 2) E.mid(acc, cur, wr, wc, fr, fq); }
            if constexpr (SP2) {
            PG8_LDB(B0, 0, 0); PG8_LDB(B1, 0, 1); PG8_SCHED; PG8_LDA(At, 0, 0); PG8_STAGE(PG8_SA(1, 1), a1 + hstepA, voffA);
            PG8_WAIT_V(8); PG8_WAIT_L(0); PG8_BAR; PG8_MMA(0, 0, At, B0); PG8_MMA(0, 1, At, B1); PG8_BAR; PG8_SCHED;
            PG8_LDA(At, 0, 1); PG8_STAGE(PG8_SB(0, 0), b2, voffB); PG8_STAGE(PG8_SB(0, 1), b2 + hstepB, voffB); PG8_STAGE(PG8_SA(0, 0), a2, voffA);
            PG8_WAIT_V(8); PG8_WAIT_L(0); PG8_BAR; PG8_MMA(1, 0, At, B0); PG8_MMA(1, 1, At, B1); PG8_BAR; PG8_SCHED;
            PG8_LDB(B0, 1, 0); PG8_LDB(B1, 1, 1); PG8_SCHED; PG8_LDA(At, 1, 0); PG8_STAGE(PG8_SA(0, 1), a2 + hstepA, voffA);
            PG8_WAIT_V(8); PG8_WAIT_L(0); PG8_BAR; PG8_MMA(0, 0, At, B0); PG8_MMA(0, 1, At, B1); PG8_BAR; PG8_SCHED;
            PG8_LDA(At, 1, 1); PG8_STAGE(PG8_SB(1, 0), b3, voffB); PG8_STAGE(PG8_SB(1, 1), b3 + hstepB, voffB); PG8_STAGE(PG8_SA(1, 0), a3, voffA);
            PG8_WAIT_V(8); PG8_WAIT_L(0); PG8_BAR; PG8_MMA(1, 0, At, B0); PG8_MMA(1, 1, At, B1); PG8_BAR; PG8_SCHED;
            } else {
            PG8_LDB(B0, 0, 0); PG8_SCHED; PG8_LDA(At, 0, 0); PG8_STAGE(PG8_SA(1, 1), a1 + hstepA, voffA);
            PG8_WAIT_L(8); PG8_BAR; PG8_WAIT_L(0); PG8_MMA(0, 0, At, B0); PG8_BAR; PG8_SCHED;
            PG8_LDB(B1, 0, 1); PG8_STAGE(PG8_SB(0, 0), b2, voffB);
            PG8_BAR; PG8_WAIT_L(0); PG8_MMA(0, 1, At, B1); PG8_BAR;
            PG8_LDA(At, 0, 1); PG8_STAGE(PG8_SA(0, 0), a2, voffA);
            PG8_BAR; PG8_WAIT_L(0); PG8_MMA(1, 0, At, B0); PG8_BAR; PG8_SCHED;
            PG8_STAGE(PG8_SB(0, 1), b2 + hstepB, voffB);
            PG8_WAIT_V(6); PG8_BAR; PG8_MMA(1, 1, At, B1); PG8_BAR;
            PG8_LDB(B0, 1, 0); PG8_SCHED; PG8_LDA(At, 1, 0); PG8_STAGE(PG8_SA(0, 1), a2 + hstepA, voffA);
            PG8_WAIT_L(8); PG8_BAR; PG8_WAIT_L(0); PG8_MMA(0, 0, At, B0); PG8_BAR; PG8_SCHED;
            PG8_LDB(B1, 1, 1); PG8_STAGE(PG8_SB(1, 0), b3, voffB);
            PG8_BAR; PG8_WAIT_L(0); PG8_MMA(0, 1, At, B1); PG8_BAR;
            PG8_LDA(At, 1, 1); PG8_STAGE(PG8_SA(1, 0), a3, voffA);
            PG8_BAR; PG8_WAIT_L(0); PG8_MMA(1, 0, At, B0); PG8_BAR; PG8_SCHED;
            PG8_STAGE(PG8_SB(1, 1), b3 + hstepB, voffB);
            PG8_WAIT_V(6); PG8_BAR; PG8_MMA(1, 1, At, B1); PG8_BAR;
            }
        }
        if constexpr (ALIGN_EPI) { if (wr == 0) PG8_BAR; }
        E(acc, cur, wr, wc, fr, fq); S.done(cur);
        if (!has_next) break;
#pragma unroll
        for (int a = 0; a < 2; ++a)
#pragma unroll
            for (int b = 0; b < 2; ++b)
#pragma unroll
                for (int m = 0; m < 4; ++m)
#pragma unroll
                    for (int n = 0; n < 2; ++n) acc[a][b][m][n] = (f32x4){0.f, 0.f, 0.f, 0.f};
        cur = nxt; cA = nA; cB = nB; ++ui;
        if constexpr (ALIGN_EPI) { if (wr == 1) PG8_BAR; }
    }
    PG8_WAIT_V(0);
    if constexpr (!ALIGN_EPI) { if (wr == 0) PG8_BAR; }
    PG8_BAR;
#undef PG8_SA
#undef PG8_SB
#undef PG8_STAGE
#undef PG8_LDA
#undef PG8_LDB
#undef PG8_MMA
#undef PG8_WAIT_V
#undef PG8_WAIT_L
#undef PG8_BAR
#undef PG8_SCHED
}
}

constexpr int NB = 4, SEQ = 4096, M = NB * SEQ, D = 2048, FF = 5632, NIN = 8544, NINP = 8704, DEPTH = 2, NMOD = 9 * D;
constexpr int NWAVES = 8;
constexpr float RMS_EPS = 1e-6f;
constexpr int NPL = 14;
constexpr int NPH = 1 + DEPTH * NPL + 1;

constexpr size_t MiB = 1u << 20;
constexpr size_t al4k(size_t x) { return (x + 4095) & ~(size_t)4095; }
constexpr size_t WS_CTL = 0, CTL_ZERO_BYTES = 1 * MiB;
constexpr size_t WS_MOD = 1 * MiB;
constexpr size_t WS_WFI = WS_MOD + al4k((size_t)DEPTH * NB * NMOD * 4);
constexpr size_t SZ_WFI1 = (size_t)2 * FF * D * 2;
constexpr size_t WS_WFO = WS_WFI + 4 * SZ_WFI1;
constexpr size_t SZ_WFO1 = (size_t)D * FF * 2;
constexpr size_t WS_WIN = WS_WFO + 4 * SZ_WFO1;
constexpr size_t SZ_WIN1 = (size_t)NINP * D * 2;
constexpr size_t WS_WUPN = WS_WIN + 2 * SZ_WIN1;
constexpr size_t SZ_WUP1 = (size_t)D * 1024 * 2;
constexpr size_t WS_WUPD = WS_WUPN + 2 * SZ_WUP1;
constexpr size_t WS_WOUT = WS_WUPD + 2 * SZ_WUP1;
constexpr size_t SZ_WOUT1 = (size_t)D * D * 2;
constexpr size_t WS_X = WS_WOUT + 2 * SZ_WOUT1;
constexpr size_t WS_H = WS_X + (size_t)M * D * 4;
constexpr size_t WS_ACT = WS_H + (size_t)M * D * 2;
constexpr size_t SZ_QN = (size_t)M * 1024 * 2, SZ_KV1 = (size_t)M * 256 * 2;
constexpr size_t WS_QN = WS_ACT + (size_t)M * FF * 2;
constexpr size_t WS_KV = WS_QN + SZ_QN;
constexpr size_t WS_QD = WS_KV + 6 * SZ_KV1 + 65536;
constexpr size_t WS_CKVR = WS_QD + SZ_QN;
constexpr size_t WS_CKVN = WS_CKVR + (size_t)M * 256 * 4;
constexpr size_t WS_QI = WS_CKVN + (size_t)M * 256 * 2;
constexpr size_t WS_KI = WS_QI + (size_t)M * 512 * 2;
constexpr size_t WS_WI = WS_KI + (size_t)M * 32 * 2;
constexpr size_t WS_GN = WS_WI + (size_t)M * 16 * 4;
constexpr size_t WS_AM = WS_GN + (size_t)M * 48 * 4;
constexpr size_t WS_QLAT = WS_AM + (size_t)M * 4096 * 2;
constexpr size_t WS_OLAT = WS_QLAT + (size_t)M * 4096 * 2;
constexpr size_t WS_CMPH = WS_OLAT + (size_t)M * 4096 * 2;
constexpr size_t WS_KCMP = WS_CMPH + (size_t)2 * 4096 * 256 * 2;
constexpr size_t WS_ON = WS_KCMP + (size_t)2 * 16 * 256 * 64 * 2;
constexpr size_t WS_OD = WS_ON + SZ_QN;
constexpr size_t WS_WC1 = WS_OD + SZ_QN;
constexpr size_t WS_WC2 = WS_WC1 + (size_t)DEPTH * 512 * 2048 * 2;
constexpr size_t WS_B1 = WS_WC2 + (size_t)DEPTH * 2 * 64 * 256 * 2;
constexpr size_t WS_WUK = WS_B1 + 4096;
constexpr size_t WS_WUVT = WS_WUK + (size_t)DEPTH * 256 * 1024 * 2;
constexpr size_t WS_END = WS_WUVT + (size_t)DEPTH * 1024 * 256 * 2;
constexpr size_t WS_YT = WS_ACT;
constexpr size_t WS_Y = WS_H;
constexpr float QSCALE = 0.125f * 1.4426950408889634f, LOG2E = 1.4426950408889634f, INDEX_SCALE = 0.04419417382415922f;

constexpr int CW_TMO = 0, CW_CODE = 1;
constexpr int CW_BAR = 4096;

constexpr int RING_OFF = 0, RING_BYTES = 131072;
constexpr int LDSCTL_OFF = RING_BYTES, MISC_OFF = LDSCTL_OFF + 320;
constexpr int EXTRA_OFF = 132096;
constexpr int LDS_BYTES = 163840;

#define GAS __attribute__((address_space(1)))
#define LAS __attribute__((address_space(3)))
typedef unsigned short bf16;
typedef unsigned v4u __attribute__((ext_vector_type(4)));
typedef float f32x4 __attribute__((ext_vector_type(4)));
typedef short bf16x8 __attribute__((ext_vector_type(8)));
typedef GAS unsigned gu32;
#define RLX_AGENT __ATOMIC_RELAXED, __HIP_MEMORY_SCOPE_AGENT
#define LDS_WAIT() asm volatile("s_waitcnt lgkmcnt(0)" ::: "memory")
#define VM_WAIT() asm volatile("s_waitcnt vmcnt(0)" ::: "memory")
__device__ __forceinline__ unsigned f2bf(float f) { unsigned u = __builtin_bit_cast(unsigned, f); return (u + 0x7fffu + ((u >> 16) & 1u)) >> 16; }
__device__ __forceinline__ unsigned pk2(float lo, float hi) { return f2bf(lo) | (f2bf(hi) << 16); }
typedef __bf16 hbf2 __attribute__((ext_vector_type(2)));
typedef float hf2 __attribute__((ext_vector_type(2)));
__device__ __forceinline__ unsigned cvtpk(float lo, float hi) { const hf2 v = {lo, hi}; return __builtin_bit_cast(unsigned, __builtin_convertvector(v, hbf2)); }
template <class T> __device__ __forceinline__ T* launder(T* p) { asm volatile("" : "+s"(p)); return p; }

#define XB_TMO      128
#define XB_XCNT(j)  (256  + 64 * (j))
#define XB_XSUB(j)  (1280 + 64 * (j))
#define XB_XGEN(j)  (2304 + 64 * (j))
#define XB_TOP      3328
#define XB_TOPGEN   3392
#define XCD_BAR_WORDS 3456
#define XB_SPIN_CAP (1u << 25)

__device__ __forceinline__ unsigned xb_ld(unsigned* p)              { return __hip_atomic_load(p, __ATOMIC_RELAXED, __HIP_MEMORY_SCOPE_AGENT); }
__device__ __forceinline__ unsigned xb_add(unsigned* p, unsigned v) { return __hip_atomic_fetch_add(p, v, __ATOMIC_RELAXED, __HIP_MEMORY_SCOPE_AGENT); }
__device__ __forceinline__ unsigned xb_xcc_id() { return (unsigned)__builtin_amdgcn_s_getreg((3 << 11) | 20) & 0xFu; }
#define XB_SPIN(cond, bar) do { unsigned _sp = 0; while (cond) { __builtin_amdgcn_s_sleep(1); \
    if ((++_sp & 255u) == 0u) { if (xb_ld(&(bar)[XB_TMO])) break; if (_sp > XB_SPIN_CAP) { atomicAdd(&(bar)[XB_TMO], 1u); break; } } } } while (0)

struct XcdBarrier { unsigned* bar; unsigned x; volatile LAS unsigned* st; };

__device__ __forceinline__ XcdBarrier xcd_barrier_post(unsigned* bar, volatile LAS unsigned* st) {
    XcdBarrier b; b.bar = bar; b.x = xb_xcc_id(); b.st = st;
    if (threadIdx.x == 0) (void)xb_add(&bar[XB_XCNT(b.x)], 1u);
    return b;
}
__device__ __forceinline__ void xcd_barrier_complete(unsigned* bar, unsigned x, unsigned& nloc, unsigned& nx) {
    const unsigned G = gridDim.x * gridDim.y * gridDim.z;
    unsigned sum, cnt, mine, sp = 0u;
    for (;;) {
        sum = 0u; cnt = 0u; mine = 0u;
#pragma unroll
        for (unsigned j = 0; j < 16; ++j) { const unsigned c = xb_ld(&bar[XB_XCNT(j)]); sum += c; cnt += (c > 0u) ? 1u : 0u; mine = (j == x) ? c : mine; }
        if (sum == G) break;
        __builtin_amdgcn_s_sleep(1);
        if ((++sp & 255u) == 0u) { if (xb_ld(&bar[XB_TMO])) break; if (sp > XB_SPIN_CAP) { atomicAdd(&bar[XB_TMO], 1u); break; } }
    }
    nloc = mine > 0u ? mine : 1u; nx = cnt > 0u ? cnt : 1u;
}
__device__ __forceinline__ void xcd_barrier(const XcdBarrier& b, int wave_s) {
    asm volatile("s_waitcnt vmcnt(0)" ::: "memory");
    __syncthreads();
    if (wave_s == 0 && fresh_lane() == 0) {
        unsigned* bar = b.bar; asm volatile("" : "+s"(bar));
        __builtin_amdgcn_s_waitcnt(0);
        unsigned nloc = b.st[0], nx = b.st[1];
        if (nloc == 0u) { xcd_barrier_complete(bar, b.x, nloc, nx); b.st[0] = nloc; b.st[1] = nx; }
        const unsigned old = xb_add(&bar[XB_XSUB(b.x)], 1u);
        const unsigned gen = old / nloc;
        if (old + 1u == (gen + 1u) * nloc) {
            __builtin_amdgcn_fence(__ATOMIC_RELEASE, "agent");
            asm volatile("s_waitcnt vmcnt(0)" ::: "memory");
            const unsigned og = xb_add(&bar[XB_TOP], 1u);
            const unsigned tg = og / nx;
            if (og + 1u == (tg + 1u) * nx) xb_add(&bar[XB_TOPGEN], 1u);
            else XB_SPIN(xb_ld(&bar[XB_TOPGEN]) == tg, bar);
            __builtin_amdgcn_fence(__ATOMIC_ACQUIRE, "agent");
            xb_add(&bar[XB_XGEN(b.x)], 1u);
            asm volatile("s_waitcnt vmcnt(0)" ::: "memory");
        } else {
            XB_SPIN(xb_ld(&bar[XB_XGEN(b.x)]) == gen, bar);
            __builtin_amdgcn_fence(__ATOMIC_ACQUIRE, "agent");
            asm volatile("s_waitcnt vmcnt(0)" ::: "memory");
        }
    }
    __syncthreads();
}

struct Frame {
    LAS unsigned char* lds;
    volatile LAS unsigned* MISC;
    gu32* ctl;
    int tid, lane, wave;
    int vcu, G;
};

__device__ __forceinline__ Frame refresh(const Frame& F0) { Frame F = F0; int t = (F0.wave << 6) | fresh_lane(); asm volatile("" : "+v"(t)); F.tid = t; F.lane = t & 63; F.wave = __builtin_amdgcn_readfirstlane(t >> 6); return F; }
template <int X> __device__ __forceinline__ float swz(float v) { return __builtin_bit_cast(float, __builtin_amdgcn_ds_swizzle(__builtin_bit_cast(int, v), (X << 10) | 0x1f)); }
struct SwapPair { unsigned a, b; };
__device__ __forceinline__ SwapPair swap32(float v) { unsigned a = __builtin_bit_cast(unsigned, v), b = a; asm volatile("" : "+v"(b)); auto r = __builtin_amdgcn_permlane32_swap(a, b, false, false); return SwapPair{r[0], r[1]}; }
__device__ __forceinline__ SwapPair swap32p(float x, float y) { unsigned a = __builtin_bit_cast(unsigned, x), b = __builtin_bit_cast(unsigned, y); asm volatile("" : "+v"(a), "+v"(b)); auto r = __builtin_amdgcn_permlane32_swap(a, b, false, false); return SwapPair{r[0], r[1]}; }
__device__ __forceinline__ SwapPair swap16p(float x, float y) { unsigned a = __builtin_bit_cast(unsigned, x), b = __builtin_bit_cast(unsigned, y); asm volatile("" : "+v"(a), "+v"(b)); auto r = __builtin_amdgcn_permlane16_swap(a, b, false, false); return SwapPair{r[0], r[1]}; }
__device__ __forceinline__ float xsum32(float v) { const SwapPair r = swap32(v); return __builtin_bit_cast(float, r.a) + __builtin_bit_cast(float, r.b); }
__device__ __forceinline__ float xmax32(float v) { const SwapPair r = swap32(v); return fmaxf(__builtin_bit_cast(float, r.a), __builtin_bit_cast(float, r.b)); }
__device__ __forceinline__ float xget32(float v, bool upper) { const SwapPair r = swap32(v); return __builtin_bit_cast(float, upper ? r.a : r.b); }
__device__ __forceinline__ SwapPair swap16(float v) { unsigned a = __builtin_bit_cast(unsigned, v), b = a; asm volatile("" : "+v"(b)); auto r = __builtin_amdgcn_permlane16_swap(a, b, false, false); return SwapPair{r[0], r[1]}; }
__device__ __forceinline__ float xsum16(float v) { const SwapPair r = swap16(v); return __builtin_bit_cast(float, r.a) + __builtin_bit_cast(float, r.b); }
__device__ __forceinline__ float xmax16(float v) { const SwapPair r = swap16(v); return fmaxf(__builtin_bit_cast(float, r.a), __builtin_bit_cast(float, r.b)); }
__device__ __forceinline__ float xget16(float v, bool oddrow) { const SwapPair r = swap16(v); return __builtin_bit_cast(float, oddrow ? r.a : r.b); }
__device__ __forceinline__ int wave_total_i(int v) {
    v += __builtin_amdgcn_update_dpp(0, v, 0xB1, 0xf, 0xf, true);
    v += __builtin_amdgcn_update_dpp(0, v, 0x4E, 0xf, 0xf, true);
    v += __builtin_amdgcn_update_dpp(0, v, 0x141, 0xf, 0xf, true);
    v += __builtin_amdgcn_update_dpp(0, v, 0x140, 0xf, 0xf, true);
    return (__builtin_amdgcn_readlane(v, 0) + __builtin_amdgcn_readlane(v, 16)) + (__builtin_amdgcn_readlane(v, 32) + __builtin_amdgcn_readlane(v, 48));
}
__device__ __forceinline__ float wave_sum(float v) {
    v += swz<1>(v); v += swz<2>(v); v += swz<4>(v); v += swz<8>(v); v += swz<16>(v);
    return xsum32(v);
}
__device__ __forceinline__ float silu_f(float g) { return g * __builtin_amdgcn_rcpf(1.0f + __builtin_amdgcn_exp2f(-1.4426950408889634f * g)); }
__device__ __forceinline__ float sigmoid_f(float g) { return __builtin_amdgcn_rcpf(1.0f + __builtin_amdgcn_exp2f(-1.4426950408889634f * g)); }

struct MapIdent { __device__ __forceinline__ int operator()(int n) const { return n; } };
struct MapFfnIn {
    __device__ __forceinline__ int operator()(int n) const { const int isu = n >= FF, c = isu ? n - FF : n; return (c >> 7) * 256 + isu * 128 + (c & 127); } };
struct MapWin {
    __device__ __forceinline__ int operator()(int n) const { return n < 2560 ? n : (n < 2608 ? n + 1840 : (n < 4448 ? n - 48 : n + 160)); } };
template <class Map>
__device__ __forceinline__ void p0_transpose_item(const float* W, int K, int N, bf16* WT, const Map& mp, LAS float* scr, int item, int lane, int ldk = 0, int koff = 0) {
    if (ldk == 0) ldk = K;
    const int nblk = N / 32, kb = item / nblk, nb = item % nblk, k0 = 64 * kb, n0 = 32 * nb;
    float tv[32];
    { const GAS float* wp = (const GAS float*)(W + (size_t)(k0 + (lane >> 5)) * N + n0 + (lane & 31));
#pragma unroll
      for (int i = 0; i < 32; ++i) tv[i] = wp[(size_t)(2 * i) * N]; }
#pragma unroll
    for (int i = 0; i < 32; ++i) scr[(2 * i + (lane >> 5)) * 33 + (lane & 31)] = tv[i];
    LDS_WAIT(); asm volatile("" ::: "memory");
    const int c = lane & 7;
#pragma unroll
    for (int j = 0; j < 4; ++j) { const int n = (lane >> 3) + 8 * j; const LAS float* s = scr + (8 * c) * 33 + n;
        v4u o; o.x = pk2(s[0 * 33], s[1 * 33]); o.y = pk2(s[2 * 33], s[3 * 33]); o.z = pk2(s[4 * 33], s[5 * 33]); o.w = pk2(s[6 * 33], s[7 * 33]);
        *(GAS v4u*)(WT + (size_t)mp(n0 + n) * ldk + koff + k0 + 8 * c) = o; }
    LDS_WAIT(); asm volatile("" ::: "memory");
}
template <class Map>
__device__ __forceinline__ void p0_transpose_item64(const float* W, int K, int N, bf16* WT, const Map& mp, LAS unsigned* scr, int item, int lane, int ldk = 0, int koff = 0) {
    if (ldk == 0) ldk = K;
    const int nblk = (N + 63) / 64, kb = item / nblk, nb = item % nblk, k0 = 64 * kb, n0 = 64 * nb;
    const bool ok = n0 + lane < N;
    float tv[64];
    { const GAS float* wp = (const GAS float*)(W + (size_t)k0 * N + n0 + (ok ? lane : 0));
#pragma unroll
      for (int i = 0; i < 64; ++i) tv[i] = wp[(size_t)i * N]; }
#pragma unroll
    for (int j = 0; j < 32; ++j) scr[j * 65 + lane] = pg8::cvt_pk_bf16(tv[2 * j], tv[2 * j + 1]);
    LDS_WAIT(); asm volatile("" ::: "memory");
    const int c = lane & 7;
#pragma unroll
    for (int jj = 0; jj < 8; ++jj) { const int n = (lane >> 3) + 8 * jj; const LAS unsigned* q = scr + (4 * c) * 65 + n;
        v4u o; o.x = q[0]; o.y = q[65]; o.z = q[130]; o.w = q[195];
        if (n0 + n < N) *(GAS v4u*)(WT + (size_t)mp(n0 + n) * ldk + koff + k0 + 8 * c) = o; }
    LDS_WAIT(); asm volatile("" ::: "memory");
}

struct Args { const float* in[22]; float* out; unsigned char* ws; int ph_lo, ph_hi, li, pad; };

struct EpiSwiglu {
    static constexpr bool PERM = true; static constexpr bool HAS_MID = false;
    bf16* O;
    __device__ __forceinline__ void operator()(const pg8::f32x4 (&acc)[2][2][4][2], const pg8::Unit& u, int wr, int wc, int fr, int fq) const {
        const int row0 = u.pm * 256 + wr * 64 + fr, col0 = u.pn * 128 + wc * 32 + 8 * fq;
        bf16* base = O + (size_t)row0 * FF + col0;
#pragma unroll
        for (int ai = 0; ai < 2; ++ai)
#pragma unroll
            for (int m = 0; m < 4; ++m) {
                pg8::u32x4 w;
                { const pg8::f32x4 g = acc[ai][0][m][0], uu = acc[ai][1][m][0];
                  w.x = pg8::cvt_pk_bf16(silu_f(g[0]) * uu[0], silu_f(g[1]) * uu[1]); w.y = pg8::cvt_pk_bf16(silu_f(g[2]) * uu[2], silu_f(g[3]) * uu[3]); }
                { const pg8::f32x4 g = acc[ai][0][m][1], uu = acc[ai][1][m][1];
                  w.z = pg8::cvt_pk_bf16(silu_f(g[0]) * uu[0], silu_f(g[1]) * uu[1]); w.w = pg8::cvt_pk_bf16(silu_f(g[2]) * uu[2], silu_f(g[3]) * uu[3]); }
                *(pg8::u32x4*)(base + (size_t)(ai * 128 + m * 16) * FF) = w;
                asm volatile("" ::: "memory");
            }
    }
};
struct EpiResid {
    static constexpr bool PERM = false; static constexpr bool HAS_MID = false;
    const float* xin; float* xout; const float* gate;
    float coef;
    __device__ __forceinline__ void operator()(const pg8::f32x4 (&acc)[2][2][4][2], const pg8::Unit& u, int wr, int wc, int fr, int fq) const {
        const int b = u.pm >> 4;
        const int row0 = u.pm * 256 + wr * 64 + fr, col0 = u.pn * 256 + wc * 32 + 4 * fq;
        pg8::f32x4 gv[2][2];
#pragma unroll
        for (int bj = 0; bj < 2; ++bj)
#pragma unroll
            for (int n = 0; n < 2; ++n) gv[bj][n] = *(const pg8::f32x4*)(gate + (size_t)b * NMOD + col0 + bj * 128 + n * 16) * coef;
#pragma unroll
        for (int ai = 0; ai < 2; ++ai)
#pragma unroll
            for (int m = 0; m < 4; ++m) { const size_t off = (size_t)(row0 + ai * 128 + m * 16) * D + col0;
#pragma unroll
                for (int bj = 0; bj < 2; ++bj)
#pragma unroll
                    for (int n = 0; n < 2; ++n) { const pg8::f32x4 xv = *(const pg8::f32x4*)(xin + off + bj * 128 + n * 16);
                        *(pg8::f32x4*)(xout + off + bj * 128 + n * 16) = xv + gv[bj][n] * acc[ai][bj][m][n]; }
                if (m & 1) asm volatile("" ::: "memory"); }
    }
};

__device__ __forceinline__ void modulate_phase(Frame& F, const float* x, bf16* H, const float* gnorm, const float* modsub) {
    const int gw = F.vcu * NWAVES + F.wave, NGW = F.G * NWAVES, per = (M + NGW - 1) / NGW;
    const int rbeg = gw * per, rend = min(rbeg + per, M);
    if (rbeg >= rend) return;
    f32x4 gs[8], sh[8]; int curb = -1;
    f32x4 v[8], nv[8];
    { const GAS f32x4* xr = (const GAS f32x4*)(x + (size_t)rbeg * D) + F.lane;
#pragma unroll
      for (int j = 0; j < 8; ++j) v[j] = xr[64 * j]; }
#pragma unroll 1
    for (int r = rbeg; r < rend; ++r) {
        { const GAS f32x4* xn = (const GAS f32x4*)(x + (size_t)min(r + 1, rend - 1) * D) + F.lane;
#pragma unroll
          for (int j = 0; j < 8; ++j) nv[j] = xn[64 * j]; }
        const int b = r >> 12;
        if (b != curb) { curb = b;
#pragma unroll
            for (int j = 0; j < 8; ++j) { const int c = 4 * F.lane + 256 * j;
                const f32x4 g = *(const GAS f32x4*)(gnorm + c), sc = *(const GAS f32x4*)(modsub + (size_t)b * NMOD + D + c);
                gs[j] = g * (sc + 1.0f); sh[j] = *(const GAS f32x4*)(modsub + (size_t)b * NMOD + c); } }
        float s = 0.f;
#pragma unroll
        for (int j = 0; j < 8; ++j) s += (v[j].x * v[j].x + v[j].y * v[j].y) + (v[j].z * v[j].z + v[j].w * v[j].w);
        const float rstd = 1.0f / sqrtf(wave_sum(s) * (1.0f / D) + RMS_EPS);
        GAS unsigned long long* o8 = (GAS unsigned long long*)(H + (size_t)r * D) + F.lane;
#pragma unroll
        for (int j = 0; j < 8; ++j) { const f32x4 y = v[j] * rstd * gs[j] + sh[j];
            o8[64 * j] = (unsigned long long)pk2(y.x, y.y) | ((unsigned long long)pk2(y.z, y.w) << 32); }
#pragma unroll
        for (int j = 0; j < 8; ++j) v[j] = nv[j];
    }
}
__device__ __forceinline__ void final_norm_phase(Frame& F, const float* x, float* out, const float* gfin) {
    const int gw = F.vcu * NWAVES + F.wave, NGW = F.G * NWAVES;
    f32x4 gs[8];
#pragma unroll
    for (int j = 0; j < 8; ++j) gs[j] = *(const GAS f32x4*)(gfin + 4 * F.lane + 256 * j);
    for (int r = gw; r < M; r += NGW) {
        const GAS f32x4* xr = (const GAS f32x4*)(x + (size_t)r * D) + F.lane;
        f32x4 v[8]; float s = 0.f;
#pragma unroll
        for (int j = 0; j < 8; ++j) { v[j] = xr[64 * j]; s += (v[j].x * v[j].x + v[j].y * v[j].y) + (v[j].z * v[j].z + v[j].w * v[j].w); }
        const float rstd = 1.0f / sqrtf(wave_sum(s) * (1.0f / D) + RMS_EPS);
        GAS f32x4* o = (GAS f32x4*)(out + (size_t)r * D) + F.lane;
#pragma unroll
        for (int j = 0; j < 8; ++j) { f32x4 y = v[j] * rstd * gs[j];
#ifdef DIAG_SANITIZE
            y.x = (y.x == y.x && fabsf(y.x) < 1e30f) ? y.x : 0.f; y.y = (y.y == y.y && fabsf(y.y) < 1e30f) ? y.y : 0.f; y.z = (y.z == y.z && fabsf(y.z) < 1e30f) ? y.z : 0.f; y.w = (y.w == y.w && fabsf(y.w) < 1e30f) ? y.w : 0.f;
#endif
            o[64 * j] = y; }
    }
}

struct EpiWin {
    static constexpr bool PERM = true; static constexpr bool HAS_MID = false;
    unsigned char* ws;
    __device__ __forceinline__ void operator()(const pg8::f32x4 (&acc)[2][2][4][2], const pg8::Unit& u, int wr, int wc, int fr, int fq) const {
        const int b = u.pm >> 4, s0 = (u.pm & 15) * 256 + wr * 64 + fr, pn = u.pn;
        const size_t row0 = (size_t)b * SEQ + s0;
#pragma unroll
        for (int bj = 0; bj < 2; ++bj) {
            const int c0 = pn * 256 + bj * 128 + wc * 32 + 8 * fq;
            int mode = 0; bf16* d16 = nullptr; float* d32 = nullptr; size_t rs = 0; float sc = 1.f;
            if (pn < 4) { d16 = (bf16*)(ws + WS_QN) + ((size_t)(b * 16 + (c0 >> 6)) * SEQ + s0) * 64 + (c0 & 63); rs = 64; sc = QSCALE; }
            else if (pn < 10) { const int c = c0 - 1024; d16 = (bf16*)(ws + WS_KV) + ((size_t)(((c >> 8) * NB + b) * 4 + ((c >> 6) & 3)) * SEQ + s0) * 64 + (c & 63); rs = 64; }
            else if (pn < 14) { d16 = (bf16*)(ws + WS_QD) + row0 * 1024 + (c0 - 2560); rs = 1024; }
            else if (pn == 14) { d32 = (float*)(ws + WS_CKVR) + row0 * 256 + (c0 - 3584); rs = 256; mode = 2; }
            else if (pn < 17) { d16 = (bf16*)(ws + WS_QI) + row0 * 512 + (c0 - 3840); rs = 512; }
            else if (pn == 17) { const int c = c0 - 4352;
                if (c < 32) { d16 = (bf16*)(ws + WS_KI) + row0 * 32 + c; rs = 32; }
                else if (c < 48) { d32 = (float*)(ws + WS_WI) + row0 * 16 + (c - 32); rs = 16; mode = 2; sc = INDEX_SCALE; }
                else if (c < 96) { d32 = (float*)(ws + WS_GN) + row0 * 48 + (c - 48); rs = 48; mode = 3; }
                else mode = 5; }
            else { d16 = (bf16*)(ws + WS_AM) + row0 * 4096 + (c0 - 4608); rs = 4096; mode = 1; }
            if (mode == 5) continue;
#pragma unroll
            for (int ai = 0; ai < 2; ++ai)
#pragma unroll
                for (int m = 0; m < 4; ++m) {
                    pg8::f32x4 v0 = acc[ai][bj][m][0], v1 = acc[ai][bj][m][1];
                    if (mode & 1) { v0 = (pg8::f32x4){sigmoid_f(v0[0]), sigmoid_f(v0[1]), sigmoid_f(v0[2]), sigmoid_f(v0[3])}; v1 = (pg8::f32x4){sigmoid_f(v1[0]), sigmoid_f(v1[1]), sigmoid_f(v1[2]), sigmoid_f(v1[3])}; }
                    else { v0 = v0 * sc; v1 = v1 * sc; }
                    const size_t ro = (size_t)(ai * 128 + m * 16) * rs;
                    if (mode < 2) { pg8::u32x4 w; w.x = pg8::cvt_pk_bf16(v0[0], v0[1]); w.y = pg8::cvt_pk_bf16(v0[2], v0[3]); w.z = pg8::cvt_pk_bf16(v1[0], v1[1]); w.w = pg8::cvt_pk_bf16(v1[2], v1[3]);
                        *(pg8::u32x4*)(d16 + ro) = w; }
                    else { *(pg8::f32x4*)(d32 + ro) = v0; *(pg8::f32x4*)(d32 + ro + 4) = v1; }
                    asm volatile("" ::: "memory");
                }
        }
    }
};
struct EpiCmp1 {
    static constexpr bool PERM = true; static constexpr bool HAS_MID = false;
    bf16* O; const float* b1;
    __device__ __forceinline__ void operator()(const pg8::f32x4 (&acc)[2][2][4][2], const pg8::Unit& u, int wr, int wc, int fr, int fq) const {
        const int row0 = u.pm * 256 + wr * 64 + fr;
#pragma unroll
        for (int bj = 0; bj < 2; ++bj) {
            const int col0 = bj * 128 + wc * 32 + 8 * fq;
            const pg8::f32x4 bA = *(const pg8::f32x4*)(b1 + u.pn * 256 + col0), bB = *(const pg8::f32x4*)(b1 + u.pn * 256 + col0 + 4);
#pragma unroll
            for (int ai = 0; ai < 2; ++ai)
#pragma unroll
                for (int m = 0; m < 4; ++m) {
                    const pg8::f32x4 v0 = acc[ai][bj][m][0] + bA, v1 = acc[ai][bj][m][1] + bB;
                    pg8::u32x4 w; w.x = pg8::cvt_pk_bf16(silu_f(v0[0]), silu_f(v0[1])); w.y = pg8::cvt_pk_bf16(silu_f(v0[2]), silu_f(v0[3]));
                    w.z = pg8::cvt_pk_bf16(silu_f(v1[0]), silu_f(v1[1])); w.w = pg8::cvt_pk_bf16(silu_f(v1[2]), silu_f(v1[3]));
                    *(pg8::u32x4*)(O + (size_t)(row0 + ai * 128 + m * 16) * 256 + col0) = w;
                    asm volatile("" ::: "memory");
                }
        }
    }
};
struct CmpOrder {
    int G, c;
    __device__ __forceinline__ bool next(int i, pg8::Unit& u) const { const int L = i * G + c; if (L >= 32) return false; u.pm = L; u.pn = L >> 4; return true; }
    __device__ __forceinline__ void a_ready(const pg8::Unit&) const {}
    __device__ __forceinline__ void done(const pg8::Unit&) const {}
};
struct EpiUpF {
    static constexpr bool PERM = false; static constexpr bool HAS_MID = true;
    const bf16* AM; bf16* Y;
    static __device__ __forceinline__ pg8::f32x4 up4(pg8::u32x2 a) { return (pg8::f32x4){__uint_as_float(a.x << 16), __uint_as_float(a.x & 0xffff0000u), __uint_as_float(a.y << 16), __uint_as_float(a.y & 0xffff0000u)}; }
    __device__ __forceinline__ void mid(pg8::f32x4 (&acc)[2][2][4][2], const pg8::Unit& u, int wr, int wc, int fr, int fq) const {
        int row0 = u.pm * 256 + wr * 64 + fr, col0 = u.pn * 256 + wc * 32 + 4 * fq;
        asm volatile("" : "+v"(row0), "+v"(col0));
#pragma unroll
        for (int ai = 0; ai < 2; ++ai)
#pragma unroll
            for (int m = 0; m < 4; ++m) { const bf16* ap = AM + (size_t)(row0 + ai * 128 + m * 16) * 4096 + col0;
#pragma unroll
                for (int bj = 0; bj < 2; ++bj)
#pragma unroll
                    for (int n = 0; n < 2; ++n) { const int c = bj * 128 + n * 16;
                        const pg8::f32x4 a0 = up4(*(const pg8::u32x2*)(ap + c)), a1 = up4(*(const pg8::u32x2*)(ap + 2048 + c));
                        pg8::f32x4 r; r[0] = a0[0] * __builtin_amdgcn_rcpf(fmaxf(a1[0], 1e-30f)); r[1] = a0[1] * __builtin_amdgcn_rcpf(fmaxf(a1[1], 1e-30f)); r[2] = a0[2] * __builtin_amdgcn_rcpf(fmaxf(a1[2], 1e-30f)); r[3] = a0[3] * __builtin_amdgcn_rcpf(fmaxf(a1[3], 1e-30f));
                        acc[ai][bj][m][n] = acc[ai][bj][m][n] * r; }
                asm volatile("" ::: "memory"); }
    }
    __device__ __forceinline__ void operator()(const pg8::f32x4 (&acc)[2][2][4][2], const pg8::Unit& u, int wr, int wc, int fr, int fq) const {
        const int row0 = u.pm * 256 + wr * 64 + fr, col0 = u.pn * 256 + wc * 32 + 4 * fq;
#pragma unroll
        for (int ai = 0; ai < 2; ++ai)
#pragma unroll
            for (int m = 0; m < 4; ++m) { const size_t r = (size_t)(row0 + ai * 128 + m * 16);
#pragma unroll
                for (int bj = 0; bj < 2; ++bj)
#pragma unroll
                    for (int n = 0; n < 2; ++n) { const int c = col0 + bj * 128 + n * 16;
                        const pg8::f32x4 y = up4(*(const pg8::u32x2*)(AM + r * 4096 + 2048 + c)) * acc[ai][bj][m][n];
                        pg8::u32x2 w; w.x = pg8::cvt_pk_bf16(y[0], y[1]); w.y = pg8::cvt_pk_bf16(y[2], y[3]);
                        *(pg8::u32x2*)(Y + r * D + c) = w; }
                asm volatile("" ::: "memory"); }
    }
};

typedef float f32x16 __attribute__((ext_vector_type(16)));
typedef short s16x4 __attribute__((ext_vector_type(4)));
typedef unsigned long long u64;
#define MFMA16(a, b, c) __builtin_amdgcn_mfma_f32_16x16x32_bf16((a), (b), (c), 0, 0, 0)
#define MFMA32(a, b, c) __builtin_amdgcn_mfma_f32_32x32x16_bf16((a), (b), (c), 0, 0, 0)

__device__ __forceinline__ void ckvnorm_rows(const float* raw, bf16* out, const float* gkv, int w0, int nw, int lane) {
    const f32x4 g = *(const GAS f32x4*)(gkv + 4 * lane);
#pragma unroll 1
    for (int r = w0; r < M; r += 4 * nw) {
        f32x4 v[4];
#pragma unroll
        for (int u = 0; u < 4; ++u) { const int rr = min(r + u * nw, M - 1); v[u] = *(const GAS f32x4*)(raw + (size_t)rr * 256 + 4 * lane); }
#pragma unroll
        for (int u = 0; u < 4; ++u) { const int rr = r + u * nw;
            const float ss = wave_sum((v[u].x * v[u].x + v[u].y * v[u].y) + (v[u].z * v[u].z + v[u].w * v[u].w));
            const float rstd = 1.0f / sqrtf(ss * (1.0f / 256.0f) + RMS_EPS);
            const f32x4 y = v[u] * rstd * g;
            if (rr < M) *(GAS unsigned long long*)(out + (size_t)rr * 256 + 4 * lane) = (unsigned long long)pk2(y.x, y.y) | ((unsigned long long)pk2(y.z, y.w) << 32); }
    }
}
__device__ __forceinline__ void qlat_items(const bf16* QD, const bf16* WUK, bf16* QLAT, int pair, int npairs, int sub, int wave, int lane) {
    const int fr = lane & 15, fq = lane >> 4, h = sub * 8 + wave;
    bf16x8 wa[16][2];
#pragma unroll
    for (int pm = 0; pm < 16; ++pm) { const int c = 64 * (pm >> 2) + 32 * ((pm >> 1) & 1) + 8 * (fr >> 2) + 4 * (pm & 1) + (fr & 3);
#pragma unroll
        for (int ks = 0; ks < 2; ++ks) wa[pm][ks] = *(const GAS bf16x8*)(WUK + (size_t)c * 1024 + h * 64 + 32 * ks + 8 * fq); }
    const bf16* qp = QD + (size_t)fr * 1024 + h * 64 + 8 * fq;
    bf16* op = QLAT + (size_t)fr * 4096 + h * 256 + 8 * fq;
    bf16x8 q0, q1, n0, n1;
    if (pair < M / 16) { q0 = *(const GAS bf16x8*)(qp + (size_t)pair * 16 * 1024); q1 = *(const GAS bf16x8*)(qp + (size_t)pair * 16 * 1024 + 32); }
#pragma unroll 1
    for (int tile = pair; tile < M / 16; tile += npairs) {
        const int nt = min(tile + npairs, M / 16 - 1);
        n0 = *(const GAS bf16x8*)(qp + (size_t)nt * 16 * 1024); n1 = *(const GAS bf16x8*)(qp + (size_t)nt * 16 * 1024 + 32);
        bf16* o = op + (size_t)tile * 16 * 4096;
#pragma unroll
        for (int ps = 0; ps < 8; ++ps) {
            f32x4 d0 = MFMA16(wa[2 * ps][0], q0, ((f32x4){0.f, 0.f, 0.f, 0.f})); d0 = MFMA16(wa[2 * ps][1], q1, d0);
            f32x4 d1 = MFMA16(wa[2 * ps + 1][0], q0, ((f32x4){0.f, 0.f, 0.f, 0.f})); d1 = MFMA16(wa[2 * ps + 1][1], q1, d1);
            pg8::u32x4 w; w.x = cvtpk(d0[0], d0[1]); w.y = cvtpk(d0[2], d0[3]); w.z = cvtpk(d1[0], d1[1]); w.w = cvtpk(d1[2], d1[3]);
            *(GAS pg8::u32x4*)(o + 32 * ps) = w;
        }
        q0 = n0; q1 = n1;
    }
}
__device__ __forceinline__ void cmp2_items(const bf16* Hd, const bf16* W2T, bf16* OUT, int it0, int it1, int w0, int nw, int lane) {
    const int fr = lane & 15, fq = lane >> 4, kv = (it0 * 16) >> 12;
    if (it0 + w0 >= it1) return;
    bf16x8 wa[4][8], hb[8];
#pragma unroll
    for (int ks = 0; ks < 8; ++ks) hb[ks] = *(const GAS bf16x8*)(Hd + (size_t)((it0 + w0) * 16 + fr) * 256 + 32 * ks + 8 * fq);
#pragma unroll
    for (int dt = 0; dt < 4; ++dt)
#pragma unroll
        for (int ks = 0; ks < 8; ++ks) wa[dt][ks] = *(const GAS bf16x8*)(W2T + (size_t)(kv * 64 + 16 * dt + fr) * 256 + 32 * ks + 8 * fq);
#pragma unroll 1
    for (int it = it0 + w0; it < it1; it += nw) {
        const int r0 = it * 16, nx = min(it + nw, it1 - 1);
        bf16x8 nb[8];
#pragma unroll
        for (int ks = 0; ks < 8; ++ks) nb[ks] = *(const GAS bf16x8*)(Hd + (size_t)(nx * 16 + fr) * 256 + 32 * ks + 8 * fq);
#pragma unroll
        for (int dt = 0; dt < 4; ++dt) {
            f32x4 d = {0.f, 0.f, 0.f, 0.f};
#pragma unroll
            for (int ks = 0; ks < 8; ++ks) d = MFMA16(wa[dt][ks], hb[ks], d);
            *(GAS unsigned long long*)(OUT + (size_t)(r0 + fr) * 64 + 16 * dt + 4 * fq) = (unsigned long long)cvtpk(d[0], d[1]) | ((unsigned long long)cvtpk(d[2], d[3]) << 32);
        }
#pragma unroll
        for (int ks = 0; ks < 8; ++ks) hb[ks] = nb[ks];
    }
}
__device__ __forceinline__ void od_items(const bf16* OLAT, const bf16* WUVT, bf16* OD, int vcu, int G, int wave, int lane) {
    const int fr = lane & 15, fq = lane >> 4, h = (vcu & 1) * 8 + wave;
    bf16x8 wa[4][8];
#pragma unroll
    for (int m = 0; m < 4; ++m) { const int d = 32 * (m >> 1) + 8 * (fr >> 2) + 4 * (m & 1) + (fr & 3);
#pragma unroll
        for (int ks = 0; ks < 8; ++ks) wa[m][ks] = *(const GAS bf16x8*)(WUVT + (size_t)(h * 64 + d) * 256 + 32 * ks + 8 * fq); }
#pragma unroll 1
  for (int tb = (vcu >> 1) * 128; tb < M; tb += (G >> 1) * 128) {
    const bf16* ip = OLAT + (size_t)(tb + fr) * 4096 + h * 256 + 8 * fq;
    bf16* op = OD + (size_t)(tb + fr) * 2048 + 1024 + h * 64 + 8 * fq;
    bf16x8 ob[8], nb[8];
#pragma unroll
    for (int ks = 0; ks < 8; ++ks) ob[ks] = *(const GAS bf16x8*)(ip + 32 * ks);
#pragma unroll 1
    for (int tile = 0; tile < 8; ++tile) {
        const bf16* np = ip + (size_t)min(tile + 1, 7) * 16 * 4096;
#pragma unroll
        for (int ks = 0; ks < 8; ++ks) nb[ks] = *(const GAS bf16x8*)(np + 32 * ks);
        f32x4 d[4];
#pragma unroll
        for (int m = 0; m < 4; ++m) { d[m] = (f32x4){0.f, 0.f, 0.f, 0.f};
#pragma unroll
            for (int ks = 0; ks < 8; ++ks) d[m] = MFMA16(wa[m][ks], ob[ks], d[m]); }
#pragma unroll
        for (int sI = 0; sI < 2; ++sI) { pg8::u32x4 w; w.x = cvtpk(d[2 * sI][0], d[2 * sI][1]); w.y = cvtpk(d[2 * sI][2], d[2 * sI][3]); w.z = cvtpk(d[2 * sI + 1][0], d[2 * sI + 1][1]); w.w = cvtpk(d[2 * sI + 1][2], d[2 * sI + 1][3]);
            *(GAS pg8::u32x4*)(op + (size_t)tile * 16 * 2048 + 32 * sI) = w; }
#pragma unroll
        for (int ks = 0; ks < 8; ++ks) ob[ks] = nb[ks];
    }
  }
}

constexpr int NS_K = 0, NS_V = 16384, NS_IMP = 32768, NS_MASK = NS_IMP + 65536;
constexpr int LUTN_OFF = EXTRA_OFF, LUTD_OFF = EXTRA_OFF + 8192, IDXL_OFF = EXTRA_OFF + 16384;
__device__ __forceinline__ int mbcnt64(u64 m) { return __builtin_amdgcn_mbcnt_hi((unsigned)(m >> 32), __builtin_amdgcn_mbcnt_lo((unsigned)m, 0u)); }
__device__ __forceinline__ int crow(int r, int hi) { return (r & 3) + 8 * (r >> 2) + 4 * hi; }
__device__ __forceinline__ int t5_bucket(int n) { return n < 16 ? n : min(31, 16 + (int)(logf((float)n * (1.0f / 16.0f)) / 2.0794415416798357f * 16.0f)); }
__device__ __forceinline__ void build_luts(Frame& F, const float* relb) {
    LAS float* ln = (LAS float*)(F.lds + LUTN_OFF); LAS float* ld = (LAS float*)(F.lds + LUTD_OFF);
    for (int i = F.tid; i < 16 * 128; i += NWAVES * 64) { const int h = i >> 7, bk = t5_bucket(i & 127); ln[i] = relb[bk * 32 + h] * LOG2E; ld[i] = relb[bk * 32 + 16 + h] * LOG2E; }
    __syncthreads();
}
struct NsaSm { float m, l; };
__device__ __forceinline__ void nsa_scores(f32x16& p0, f32x16& p1, LAS const unsigned char* Kt, const bf16x8 (&qr)[4], float cin, int r32, int hi) {
#pragma unroll
    for (int r = 0; r < 16; ++r) { p0[r] = cin; p1[r] = cin; }
    const int sw = (r32 >> 1) & 7;
    LAS const unsigned char* k0 = Kt + r32 * 128; LAS const unsigned char* k1 = k0 + 32 * 128;
#pragma unroll
    for (int d0 = 0; d0 < 4; ++d0) {
        const int ch = ((2 * d0 + hi) ^ sw) << 4;
        const bf16x8 a0 = *(LAS const bf16x8*)(k0 + ch), a1 = *(LAS const bf16x8*)(k1 + ch);
        p0 = MFMA32(a0, qr[d0], p0); p1 = MFMA32(a1, qr[d0], p1);
    }
}
__device__ __forceinline__ void nsa_near(f32x16& p0, f32x16& p1, int dbase, int stride, int lim, LAS const float* lut, int hi) {
    int db = dbase - stride * 4 * hi; asm volatile("" : "+v"(db));
#pragma unroll
    for (int r = 0; r < 16; ++r) {
        const int d0 = db - stride * ((r & 3) + 8 * (r >> 2)), d1 = d0 - stride * 32;
        const float b0 = lut[min(max(d0, 0), 127)], b1 = lut[min(max(d1, 0), 127)];
        p0[r] = (d0 >= 0 && d0 < lim) ? p0[r] + b0 : -INFINITY; p1[r] = (d1 >= 0 && d1 < lim) ? p1[r] + b1 : -INFINITY;
    }
}
__device__ __forceinline__ float nsa_rowmax(const f32x16& p0, const f32x16& p1) {
    float a = __builtin_elementwise_maximum(p0[0], p1[0]);
#pragma unroll
    for (int r = 1; r < 16; ++r) a = __builtin_elementwise_maximum(a, __builtin_elementwise_maximum(p0[r], p1[r]));
    return xmax32(a);
}
__device__ __forceinline__ void nsa_pv(f32x16& o0, f32x16& o1, LAS const unsigned char* Vt, const bf16x8 (&pk)[4], int lane) {
    const int hi = lane >> 5, G = (lane >> 4) & 1, q_ = (lane & 15) >> 2, p_ = lane & 3;
    const int sw = ((q_ >> 1) & 1) << 2;
    const int rowoff = (4 * hi + q_) * 128 + (p_ & 1) * 8;
    const int c0 = (((2 * G + (p_ >> 1)) ^ sw) << 4), c1 = (((4 + 2 * G + (p_ >> 1)) ^ sw) << 4);
#pragma unroll
    for (int sb = 0; sb < 2; ++sb) {
        s16x4 al[2][2], ah[2][2];
#pragma unroll
        for (int s2 = 0; s2 < 2; ++s2) { LAS const unsigned char* base = Vt + (2 * sb + s2) * 16 * 128 + rowoff;
            al[s2][0] = __builtin_bit_cast(s16x4, __builtin_amdgcn_ds_read_tr16_b64_v4i16((LAS s16x4*)(base + c0)));
            ah[s2][0] = __builtin_bit_cast(s16x4, __builtin_amdgcn_ds_read_tr16_b64_v4i16((LAS s16x4*)(base + c0 + 8 * 128)));
            al[s2][1] = __builtin_bit_cast(s16x4, __builtin_amdgcn_ds_read_tr16_b64_v4i16((LAS s16x4*)(base + c1)));
            ah[s2][1] = __builtin_bit_cast(s16x4, __builtin_amdgcn_ds_read_tr16_b64_v4i16((LAS s16x4*)(base + c1 + 8 * 128))); }
#pragma unroll
        for (int s2 = 0; s2 < 2; ++s2) {
            const bf16x8 v0 = {al[s2][0][0], al[s2][0][1], al[s2][0][2], al[s2][0][3], ah[s2][0][0], ah[s2][0][1], ah[s2][0][2], ah[s2][0][3]};
            const bf16x8 v1 = {al[s2][1][0], al[s2][1][1], al[s2][1][2], al[s2][1][3], ah[s2][1][0], ah[s2][1][1], ah[s2][1][2], ah[s2][1][3]};
            o0 = MFMA32(v0, pk[2 * sb + s2], o0); o1 = MFMA32(v1, pk[2 * sb + s2], o1); }
    }
}
__device__ __forceinline__ void nsa_pack(bf16x8 (&pk)[4], const f32x16& p0, const f32x16& p1) {
#pragma unroll
    for (int s = 0; s < 2; ++s) {
        pg8::u32x4 w0, w1;
        w0.x = cvtpk(p0[8 * s + 0], p0[8 * s + 1]); w0.y = cvtpk(p0[8 * s + 2], p0[8 * s + 3]); w0.z = cvtpk(p0[8 * s + 4], p0[8 * s + 5]); w0.w = cvtpk(p0[8 * s + 6], p0[8 * s + 7]);
        w1.x = cvtpk(p1[8 * s + 0], p1[8 * s + 1]); w1.y = cvtpk(p1[8 * s + 2], p1[8 * s + 3]); w1.z = cvtpk(p1[8 * s + 4], p1[8 * s + 5]); w1.w = cvtpk(p1[8 * s + 6], p1[8 * s + 7]);
        pk[s] = __builtin_bit_cast(bf16x8, w0); pk[2 + s] = __builtin_bit_cast(bf16x8, w1);
    }
}
__device__ __forceinline__ void nsa_online(f32x16& p0, f32x16& p1, NsaSm& st, f32x16& o0, f32x16& o1, LAS const unsigned char* Vt, int lane, float cin) {
    const float mx = nsa_rowmax(p0, p1) + cin, mn = fmaxf(st.m, mx), alpha = __builtin_amdgcn_exp2f(st.m - mn), off = mn - cin;
    st.m = mn; float sum = 0.f;
#pragma unroll
    for (int r = 0; r < 16; ++r) { p0[r] = __builtin_amdgcn_exp2f(p0[r] - off); p1[r] = __builtin_amdgcn_exp2f(p1[r] - off); sum += p0[r] + p1[r]; }
    st.l = st.l * alpha + sum;
    if (__any(alpha != 1.0f)) {
#pragma unroll
        for (int r = 0; r < 16; ++r) { o0[r] *= alpha; o1[r] *= alpha; } }
    bf16x8 pk[4]; nsa_pack(pk, p0, p1);
    nsa_pv(o0, o1, Vt, pk, lane);
}
__device__ __forceinline__ void nsa_stage_store(LAS unsigned char* lds, int buf, int tid, const v4u& kr, const v4u& vr) {
    const int key = tid >> 3, ch = tid & 7;
    *(LAS v4u*)(lds + NS_K + buf * 8192 + key * 128 + ((ch ^ ((key >> 1) & 7)) << 4)) = kr;
    *(LAS v4u*)(lds + NS_V + buf * 8192 + key * 128 + ((ch ^ (((key >> 1) & 1) << 2)) << 4)) = vr;
}

__device__ __forceinline__ void nsa_unit(Frame& F, int b, int g, int i, const bf16* QN, const bf16* KV, const bf16* KCMP, const float* GN, bf16* ON, int& itc) {
    const int tid = F.tid, lane = F.lane, r32 = lane & 31, hi = lane >> 5, hh = F.wave & 3, th = F.wave >> 2, h = 4 * g + hh;
    const int t0 = 64 * i, tw0 = t0 + 32 * th, t = tw0 + r32;
    LAS unsigned char* lds = F.lds + RING_OFF;
    LAS const float* lut = (LAS const float*)(F.lds + LUTN_OFF) + h * 128;
    const float b31 = lut[127];
    bf16x8 qr[4];
#pragma unroll
    for (int d0 = 0; d0 < 4; ++d0) qr[d0] = *(const GAS bf16x8*)(QN + ((size_t)(b * 16 + h) * SEQ + t) * 64 + 16 * d0 + 8 * hi);
    const float* gp = GN + (size_t)(b * SEQ + t) * 48 + h * 3;
    const float g0 = gp[0], g1 = gp[1], g2 = gp[2];
    const int bg = b * 4 + g;
    const bf16 *Kc, *Vc, *Ks, *Vs, *Kw, *Vw;
    f32x16 oc0, oc1;
    LAS float* accl = (LAS float*)(lds + NS_IMP) + F.wave * 2048 + lane;
    v4u kr, vr; const unsigned toff = (unsigned)tid * 16u;
#define NSA_LOAD(Kp, Vp, jb) do { kr = *(const GAS v4u*)((const GAS char*)((Kp) + (size_t)(jb) * 4096) + toff); vr = *(const GAS v4u*)((const GAS char*)((Vp) + (size_t)(jb) * 4096) + toff); } while (0)
#define NSA_STAGE() do { nsa_stage_store(lds, itc & 1, tid, kr, vr); } while (0)
#define NSA_BAR() asm volatile("s_waitcnt lgkmcnt(0)\n\ts_barrier" ::: "memory")
#define NSA_KT (lds + NS_K + (itc & 1) * 8192)
#define NSA_VT (lds + NS_V + (itc & 1) * 8192)
    const int ncb = ((min((t0 + 32) >> 4, 254)) >> 6) + 1;
    NsaSm sc{-1e30f, 0.f};
    Kc = launder(KCMP) + (size_t)bg * 256 * 64; Vc = Kc + (size_t)16 * 256 * 64;
    NSA_LOAD(Kc, Vc, 0);
    for (int jb = 0; jb < ncb; ++jb) {
        NSA_STAGE(); if (jb + 1 < ncb) NSA_LOAD(Kc, Vc, jb + 1); else NSA_LOAD(Kc, Vc, 0);
        NSA_BAR();
        f32x16 p0, p1;
        const int dmin = tw0 - 31 - 16 * (64 * jb + 63);
        nsa_scores(p0, p1, NSA_KT, qr, 0.f, r32, hi);
        float cin = b31;
        if (dmin < 113) { nsa_near(p0, p1, t - 31 - 1024 * jb, 16, 1 << 30, lut, hi); cin = 0.f; }
        const float mx = nsa_rowmax(p0, p1) + cin, mn = fmaxf(sc.m, mx), alpha = __builtin_amdgcn_exp2f(sc.m - mn), off = mn - cin;
        sc.m = mn; float sum = 0.f;
#pragma unroll
        for (int r = 0; r < 16; ++r) sum += __builtin_amdgcn_exp2f(p0[r] - off) + __builtin_amdgcn_exp2f(p1[r] - off);
        sc.l = sc.l * alpha + sum;
        ++itc;
    }
    {
        const float lt = xsum32(sc.l), inv = lt > 0.f ? 1.0f / lt : 0.f;
        f32x16 o0, o1;
#pragma unroll
        for (int r = 0; r < 16; ++r) { o0[r] = 0.f; o1[r] = 0.f; }
        float carry = 0.f;
        LAS float* imp = (LAS float*)(lds + NS_IMP) + (hh * 64 + 32 * th + r32) * 64;
#pragma unroll 1
        for (int jb = 0; jb < 4; ++jb) {
            float X[8];
#pragma unroll
            for (int a = 0; a < 8; ++a) X[a] = 0.f;
            if (jb < ncb) {
                NSA_STAGE(); if (jb + 1 < ncb) NSA_LOAD(Kc, Vc, jb + 1);
                NSA_BAR();
                f32x16 p0, p1;
                const int dmin = tw0 - 31 - 16 * (64 * jb + 63);
                nsa_scores(p0, p1, NSA_KT, qr, 0.f, r32, hi);
                float off = sc.m - b31;
                if (dmin < 113) { nsa_near(p0, p1, t - 31 - 1024 * jb, 16, 1 << 30, lut, hi); off = sc.m; }
#pragma unroll
                for (int r = 0; r < 16; ++r) { p0[r] = __builtin_amdgcn_exp2f(p0[r] - off) * inv; p1[r] = __builtin_amdgcn_exp2f(p1[r] - off) * inv; }
                X[0] = hi ? 0.f : carry;
#pragma unroll
                for (int a = 0; a < 8; ++a) {
                    const int ra = 4 * (a & 3);
                    const float e0 = a < 4 ? p0[ra] : p1[ra], e1 = a < 4 ? p0[ra + 1] : p1[ra + 1], e2 = a < 4 ? p0[ra + 2] : p1[ra + 2], e3 = a < 4 ? p0[ra + 3] : p1[ra + 3];
                    const float other = xget32(e3, hi != 0);
                    X[a] += (e0 + e1) + (e2 + e3);
                    if (hi) X[a] += other; else { if (a < 7) X[a + 1] += other; else carry = other; }
                }
                bf16x8 pk[4]; nsa_pack(pk, p0, p1);
                nsa_pv(o0, o1, NSA_VT, pk, lane);
                ++itc;
            }
#pragma unroll
            for (int a = 0; a < 8; ++a) imp[16 * jb + 2 * a + hi] = X[a];
        }
#pragma unroll
        for (int r = 0; r < 16; ++r) { oc0[r] = g0 * o0[r]; oc1[r] = g0 * o1[r]; }
    }
    __syncthreads();
    {
        LAS const float* impb = (LAS const float*)(lds + NS_IMP);
        LAS u64* maskl = (LAS u64*)(lds + NS_MASK);
#pragma unroll 1
        for (int q = 0; q < 8; ++q) {
            const int tok = F.wave * 8 + q, j = lane;
            const float v = ((impb[(0 * 64 + tok) * 64 + j] + impb[(1 * 64 + tok) * 64 + j]) + impb[(2 * 64 + tok) * 64 + j]) + impb[(3 * 64 + tok) * 64 + j];
            const bool vis = j <= i, forced = vis && ((j == 0) | (j == i) | (j == i - 1)), cand = vis && !forced;
            const int k = 16 - __builtin_popcountll(__ballot(forced)), ncand = __builtin_popcountll(__ballot(cand));
            const float vc = cand ? v : -INFINITY;
            u64 msk;
            if (ncand <= k) msk = __ballot(vis);
            else {
                float lo = 0.f, hi = 8.f, thr = 0.f;
                for (int itn = 0; itn < 64; ++itn) {
                    const float mid = 0.5f * (lo + hi);
                    if (!(mid > lo && mid < hi)) { thr = lo; break; }
                    const int c = __builtin_popcountll(__ballot(vc >= mid));
                    if (c == k) { thr = mid; break; }
                    if (c > k) lo = mid; else hi = mid;
                    thr = lo;
                }
                const int need = k - __builtin_popcountll(__ballot(vc > thr));
                const bool eq = vc == thr; const u64 meq = __ballot(eq);
                msk = __ballot(forced || (vc > thr) || (eq && mbcnt64(meq) < need));
            }
            if (lane == 0) maskl[tok] = msk;
        }
    }
    __syncthreads();
    const u64 mymask = ((LAS const u64*)(lds + NS_MASK))[32 * th + r32];
#pragma unroll
    for (int r = 0; r < 16; ++r) { accl[r * 64] = oc0[r]; accl[(16 + r) * 64] = oc1[r]; }
    {
        NsaSm ss{-1e30f, 0.f}; f32x16 o0, o1;
#pragma unroll
        for (int r = 0; r < 16; ++r) { o0[r] = 0.f; o1[r] = 0.f; }
        Ks = launder(KV) + ((size_t)(2 * NB * 4 + bg) * SEQ) * 64; Vs = Ks + ((size_t)NB * 4 * SEQ) * 64;
        NSA_LOAD(Ks, Vs, 0);
#ifndef NSA_SKIP_SEL
        for (int jb = 0; jb <= i; ++jb) {
            NSA_STAGE(); if (jb < i) NSA_LOAD(Ks, Vs, jb + 1);
            NSA_BAR();
            const bool att = (mymask >> jb) & 1ull;
            f32x16 p0, p1;
            const int dmin = tw0 - 64 * jb - 63;
            nsa_scores(p0, p1, NSA_KT, qr, 0.f, r32, hi);
            float cin = att ? b31 : -INFINITY;
            if (dmin < 113) { nsa_near(p0, p1, t - 64 * jb, 1, 1 << 30, lut, hi); cin = att ? 0.f : -INFINITY; }
            nsa_online(p0, p1, ss, o0, o1, NSA_VT, lane, cin);
            ++itc;
        }
#endif
        const float lt = xsum32(ss.l), f = lt > 0.f ? g1 / lt : 0.f;
#pragma unroll
        for (int r = 0; r < 16; ++r) { accl[r * 64] += f * o0[r]; accl[(16 + r) * 64] += f * o1[r]; }
    }
    {
        NsaSm sw{-1e30f, 0.f}; f32x16 o0, o1;
#pragma unroll
        for (int r = 0; r < 16; ++r) { o0[r] = 0.f; o1[r] = 0.f; }
#ifdef WIN_AS_CAUSAL
        const int j0 = 0;
#else
        const int j0 = max(i - 8, 0);
#endif
        Kw = launder(KV) + ((size_t)(4 * NB * 4 + bg) * SEQ) * 64; Vw = Kw + ((size_t)NB * 4 * SEQ) * 64;
        NSA_LOAD(Kw, Vw, j0);
#ifndef NSA_SKIP_WIN
        for (int jb = j0; jb <= i; ++jb) {
            NSA_STAGE(); if (jb < i) NSA_LOAD(Kw, Vw, jb + 1);
            NSA_BAR();
            f32x16 p0, p1;
            const int dmin = tw0 - 64 * jb - 63, dmax = tw0 + 31 - 64 * jb;
#ifdef WIN_AS_CAUSAL
            nsa_scores(p0, p1, NSA_KT, qr, 0.f, r32, hi);
            float cin = b31;
            if (dmin < 113) { nsa_near(p0, p1, t - 64 * jb, 1, 1 << 30, lut, hi); cin = 0.f; }
#else
            nsa_scores(p0, p1, NSA_KT, qr, 0.f, r32, hi);
            float cin = b31;
            if (!(dmin >= 113 && dmax < 512)) { nsa_near(p0, p1, t - 64 * jb, 1, 512, lut, hi); cin = 0.f; }
#endif
            nsa_online(p0, p1, sw, o0, o1, NSA_VT, lane, cin);
            ++itc;
        }
#endif
        const float lt = xsum32(sw.l), f = lt > 0.f ? g2 / lt : 0.f;
#pragma unroll
        for (int r = 0; r < 16; ++r) { o0[r] = accl[r * 64] + f * o0[r]; o1[r] = accl[(16 + r) * 64] + f * o1[r]; }
        bf16* op = ON + (size_t)(b * SEQ + t) * 2048 + h * 64 + 4 * hi;
#pragma unroll
        for (int a = 0; a < 4; ++a) {
            *(GAS unsigned long long*)(op + 8 * a) = (unsigned long long)pk2(o0[4 * a], o0[4 * a + 1]) | ((unsigned long long)pk2(o0[4 * a + 2], o0[4 * a + 3]) << 32);
            *(GAS unsigned long long*)(op + 32 + 8 * a) = (unsigned long long)pk2(o1[4 * a], o1[4 * a + 1]) | ((unsigned long long)pk2(o1[4 * a + 2], o1[4 * a + 3]) << 32);
        }
    }
#undef NSA_LOAD
#undef NSA_STAGE
#undef NSA_BAR
#undef NSA_KT
#undef NSA_VT
}

__device__ __forceinline__ unsigned f2sortable(float f) { const unsigned u = __builtin_bit_cast(unsigned, f); return u ^ ((u >> 31) ? 0xffffffffu : 0x80000000u); }

__device__ __forceinline__ void dsa_token(Frame& F, int b, int t, const bf16* QI, const bf16* KI, const float* WI, const bf16* CKVN, const bf16* QLAT, bf16* OLAT) {
    const int lane = F.lane, fr = lane & 15, fq = lane >> 4;
    const size_t row = (size_t)b * SEQ + t;
    LAS unsigned short* idxl = (LAS unsigned short*)(F.lds + IDXL_OFF + F.wave * 1024);
    LAS unsigned char* Cb = F.lds + RING_OFF + F.wave * 16384;
    LAS const float* lut = (LAS const float*)(F.lds + LUTD_OFF) + fr * 128;
    const int cmax = t >> 6;
    int nsel;
#ifndef REP_DSA_IDX
#define REP_DSA_IDX 1
#endif
#ifndef REP_DSA_ATT
#define REP_DSA_ATT 1
#endif
    for (int rep_i = 0; rep_i < REP_DSA_IDX; ++rep_i)
    {
        float sc[64];
        const bf16x8 qa = *(const GAS bf16x8*)(QI + row * 512 + fr * 32 + 8 * fq);
        const f32x4 w4 = *(const GAS f32x4*)(WI + row * 16 + 4 * fq);
        const GAS bf16* kp = (const GAS bf16*)(KI + ((size_t)b * SEQ + fr) * 32 + 8 * fq);
        bf16x8 kbuf[3][4];
        float vmax = -INFINITY, vmin = INFINITY;
#define DSA_KLOAD(c, ahead) do { _Pragma("unroll") for (int tau = 0; tau < 4; ++tau) kbuf[(c) % 3][tau] = *(const GAS bf16x8*)(kp + ((ahead) * 64 + 16 * tau) * 32); } while (0)
        const int cmax4 = cmax | 3;
        DSA_KLOAD(0, 0); DSA_KLOAD(1, 1);
#pragma unroll
        for (int c = 0; c < 64; ++c) sc[c] = -INFINITY;
#pragma unroll
        for (int g4 = 0; g4 < 16; ++g4) {
            if (4 * g4 <= cmax) {
#pragma unroll
                for (int c = 4 * g4; c < 4 * g4 + 4; ++c) {
                    asm volatile("" : "+v"(kp));
                    if (c + 2 < 64) { if (c + 2 <= cmax4) DSA_KLOAD(c + 2, 2); }
                    float v[4];
#pragma unroll
                    for (int tau = 0; tau < 4; ++tau) {
                        const f32x4 d = MFMA16(qa, kbuf[c % 3][tau], ((f32x4){0.f, 0.f, 0.f, 0.f}));
                        typedef int i32x4_ __attribute__((ext_vector_type(4)));
                        const f32x4 rl = __builtin_bit_cast(f32x4, __builtin_elementwise_max(__builtin_bit_cast(i32x4_, d), ((i32x4_){0, 0, 0, 0})));
                        v[tau] = fmaf(w4.w, rl[3], fmaf(w4.z, rl[2], fmaf(w4.y, rl[1], w4.x * rl[0])));
                    }
                    const SwapPair r0 = swap32p(v[0], v[2]), r1 = swap32p(v[1], v[3]);
                    const float a0 = __builtin_bit_cast(float, r0.a) + __builtin_bit_cast(float, r0.b), a1 = __builtin_bit_cast(float, r1.a) + __builtin_bit_cast(float, r1.b);
                    const SwapPair r2 = swap16p(a0, a1);
                    const float keep = __builtin_bit_cast(float, r2.a) + __builtin_bit_cast(float, r2.b);
                    const bool cand = 64 * c + lane <= t;
                    sc[c] = cand ? keep : -INFINITY; vmax = fmaxf(vmax, sc[c]); vmin = fminf(vmin, cand ? keep : INFINITY);
                    kp += 64 * 32;
                }
            }
        }
#undef DSA_KLOAD
        if (t < 256) {
            nsel = t + 1;
#pragma unroll
            for (int c = 0; c < 4; ++c) idxl[64 * c + lane] = (64 * c + lane <= t) ? (unsigned short)(64 * c + lane) : (unsigned short)0;
        } else {
            nsel = 256;
#define DSA_COUNT_L(OP, X, out) do { int cnt_ = 0; \
            _Pragma("unroll") for (int c = 0; c < 16; ++c) cnt_ += (sc[c] OP (X)) ? 1 : 0; \
            if (cmax >= 16) { _Pragma("unroll") for (int c = 16; c < 32; ++c) cnt_ += (sc[c] OP (X)) ? 1 : 0; } \
            if (cmax >= 32) { _Pragma("unroll") for (int c = 32; c < 48; ++c) cnt_ += (sc[c] OP (X)) ? 1 : 0; } \
            if (cmax >= 48) { _Pragma("unroll") for (int c = 48; c < 64; ++c) cnt_ += (sc[c] OP (X)) ? 1 : 0; } \
            out = cnt_; } while (0)
#define DSA_COUNT(OP, X, out) do { int l_; DSA_COUNT_L(OP, X, l_); out = wave_total_i(l_); } while (0)
            float lo = vmin, hi = vmax;
            lo = fminf(lo, swz<1>(lo)); lo = fminf(lo, swz<2>(lo)); lo = fminf(lo, swz<4>(lo)); lo = fminf(lo, swz<8>(lo)); lo = fminf(lo, swz<16>(lo)); { const SwapPair r = swap32(lo); lo = fminf(__builtin_bit_cast(float, r.a), __builtin_bit_cast(float, r.b)); }
            hi = fmaxf(hi, swz<1>(hi)); hi = fmaxf(hi, swz<2>(hi)); hi = fmaxf(hi, swz<4>(hi)); hi = fmaxf(hi, swz<8>(hi)); hi = fmaxf(hi, swz<16>(hi)); hi = xmax32(hi);
            float thr = lo; int c0; DSA_COUNT(>=, hi, c0);
            if (c0 >= 256) thr = hi;
            else {
                for (int itn = 0; itn < 64; ++itn) {
                    const float mid = lo + 0.5f * (hi - lo);
                    if (!(mid > lo && mid < hi)) { thr = lo; break; }
                    int cnt; DSA_COUNT(>=, mid, cnt);
                    if (cnt == 256) { thr = mid; break; }
                    if (cnt > 256) lo = mid; else hi = mid;
                    thr = lo;
                }
            }
            int nl; DSA_COUNT_L(>, thr, nl);
            const int cgt = wave_total_i(nl);
            const int need = 256 - cgt;
            if (need == 0) {
                int inc = nl;
                inc += __builtin_amdgcn_update_dpp(0, inc, 0x111, 0xf, 0xf, true);
                inc += __builtin_amdgcn_update_dpp(0, inc, 0x112, 0xf, 0xf, true);
                inc += __builtin_amdgcn_update_dpp(0, inc, 0x114, 0xf, 0xf, true);
                inc += __builtin_amdgcn_update_dpp(0, inc, 0x118, 0xf, 0xf, true);
                const int r0 = __builtin_amdgcn_readlane(inc, 15), r1 = r0 + __builtin_amdgcn_readlane(inc, 31), r2 = r1 + __builtin_amdgcn_readlane(inc, 47);
                int off = inc - nl + (fq == 0 ? 0 : fq == 1 ? r0 : fq == 2 ? r1 : r2);
                int key = lane; asm volatile("" : "+v"(key));
                const int dump = key + 256;
#pragma unroll
                for (int g4 = 0; g4 < 16; ++g4) {
                    if (4 * g4 <= cmax) {
#pragma unroll
                        for (int c = 4 * g4; c < 4 * g4 + 4; ++c) { const bool sel = sc[c] > thr;
                            idxl[sel ? off : dump] = (unsigned short)key; off += sel ? 1 : 0; key += 64; asm volatile("" : "+v"(key)); }
                    }
                }
            } else {
            int base = 0, eqb = 0;
#pragma unroll
            for (int g4 = 0; g4 < 16; ++g4) {
                if (4 * g4 <= cmax) {
#pragma unroll
                    for (int c = 4 * g4; c < 4 * g4 + 4; ++c) {
                        const bool eq = sc[c] == thr; const u64 meq = __ballot(eq);
                        const bool sel = (sc[c] > thr) || (eq && (eqb + mbcnt64(meq) < need));
                        const u64 ms = __ballot(sel);
                        if (sel) idxl[base + mbcnt64(ms)] = (unsigned short)(64 * c + lane);
                        base += __builtin_popcountll(ms); eqb += __builtin_popcountll(meq);
                    }
                }
            }
            }
#undef DSA_COUNT_L
#undef DSA_COUNT
        }
    }
    for (int rep_a = 0; rep_a < REP_DSA_ATT; ++rep_a) {
    bf16x8 qf[8];
    { const bf16* qp = QLAT + row * 4096 + fr * 256 + 8 * fq;
#pragma unroll
      for (int ks = 0; ks < 8; ++ks) qf[ks] = *(const GAS bf16x8*)(qp + 32 * ks); }
    f32x4 o[16];
#pragma unroll
    for (int ct = 0; ct < 16; ++ct) o[ct] = (f32x4){0.f, 0.f, 0.f, 0.f};
    float m = -1e30f, l = 0.f;
    const int nhc = (nsel + 15) >> 4;
    const GAS char* Cbase = (const GAS char*)(CKVN + (size_t)b * SEQ * 256) + fq * 16;
    bf16x8 crA[8], crB[8];
#define DSA_LOADT(cr, hc) do { const GAS char* src_ = Cbase + (size_t)idxl[16 * (hc) + fr] * 512; \
        _Pragma("unroll") for (int ks = 0; ks < 8; ++ks) cr[ks] = *(const GAS bf16x8*)(src_ + ks * 64); } while (0)
#define DSA_TILE(cr, hc) do { \
        const s16x4 ia = *(LAS const s16x4*)(idxl + 16 * (hc) + 4 * fq); \
        f32x4 s0 = {0.f, 0.f, 0.f, 0.f}; \
        _Pragma("unroll") for (int ks = 0; ks < 8; ++ks) s0 = MFMA16(cr[ks], qf[ks], s0); \
        _Pragma("unroll") for (int ks = 0; ks < 8; ++ks) *(LAS bf16x8*)(Cb + (4 * ks + fq) * 256 + fr * 16) = cr[ks]; \
        if ((hc) + 2 < nhc) DSA_LOADT(cr, (hc) + 2); \
        float sv[4], bz[4]; \
        _Pragma("unroll") for (int r = 0; r < 4; ++r) bz[r] = lut[min(max(t - (int)(unsigned short)ia[r], 0), 127)];     \
        _Pragma("unroll") for (int r = 0; r < 4; ++r) { const float v_ = s0[r] * QSCALE + bz[r]; sv[r] = (16 * (hc) + 4 * fq + r < nsel) ? v_ : -INFINITY; } \
        float mx = fmaxf(fmaxf(sv[0], sv[1]), fmaxf(sv[2], sv[3])); \
        mx = xmax16(mx); mx = xmax32(mx); \
        const float mn = fmaxf(m, mx), alpha = __builtin_amdgcn_exp2f(m - mn); m = mn; \
        float sum = 0.f; \
        _Pragma("unroll") for (int r = 0; r < 4; ++r) { sv[r] = __builtin_amdgcn_exp2f(sv[r] - mn); sum += sv[r]; } \
        l = l * alpha + sum; \
        if (__any(alpha != 1.0f)) { _Pragma("unroll") for (int ct = 0; ct < 16; ++ct) o[ct] = o[ct] * alpha; } \
        pg8::u32x2 pw; pw.x = cvtpk(sv[0], sv[1]); pw.y = cvtpk(sv[2], sv[3]); \
        const s16x4 pb = __builtin_bit_cast(s16x4, pw); \
        _Pragma("unroll") for (int cb = 0; cb < 2; ++cb) { s16x4 tf_[8];                      \
            _Pragma("unroll") for (int c8 = 0; c8 < 8; ++c8) tf_[c8] = __builtin_bit_cast(s16x4, __builtin_amdgcn_ds_read_tr16_b64_v4i16((LAS s16x4*)(rb + (8 * cb + c8) * 512))); \
            __builtin_amdgcn_sched_barrier(0); \
            _Pragma("unroll") for (int c8 = 0; c8 < 8; ++c8) o[8 * cb + c8] = __builtin_amdgcn_mfma_f32_16x16x16bf16_1k(tf_[c8], pb, o[8 * cb + c8], 0, 0, 0); \
            __builtin_amdgcn_sched_barrier(0); } \
    } while (0)
    LAS const unsigned char* rb = Cb + ((fr & 3) >> 1) * 256 + (4 * fq + (fr >> 2)) * 16 + (fr & 1) * 8;
    DSA_LOADT(crA, 0); if (nhc > 1) DSA_LOADT(crB, 1);
    for (int hc = 0; hc < nhc; hc += 2) {
        DSA_TILE(crA, hc);
        if (hc + 1 < nhc) DSA_TILE(crB, hc + 1);
    }
#undef DSA_TILE
#undef DSA_LOADT
    const float lt = xsum16(l); const float ltt = xsum32(lt); const float inv = ltt > 0.f ? 1.0f / ltt : 0.f;
    asm volatile("s_waitcnt lgkmcnt(0)" ::: "memory");
    bf16* op = OLAT + row * 4096 + fr * 256 + 4 * fq;
#pragma unroll
    for (int ct = 0; ct < 16; ++ct) *(GAS unsigned long long*)(op + 16 * ct) = (unsigned long long)pk2(o[ct][0] * inv, o[ct][1] * inv) | ((unsigned long long)pk2(o[ct][2] * inv, o[ct][3] * inv) << 32);
    }
}

__device__ __forceinline__ void p0_prologue(Frame& F, const Args& a) {
    unsigned char* ws = a.ws;
    {
        LAS float* cact = (LAS float*)(F.lds + RING_OFF);
        LAS float* red = (LAS float*)(F.lds + RING_OFF + 32768);
        const float* c = a.in[1];
        for (int i = F.tid; i < NB * D; i += NWAVES * 64) cact[i] = silu_f(c[i]);
        __syncthreads();
        float* MOD = (float*)(ws + WS_MOD);
        const int cg = F.tid & 7, kg = F.tid >> 3;
        constexpr int NIT = DEPTH * (NMOD / 32);
        for (int it = F.vcu; it < NIT; it += F.G) {
            const int l = it / (NMOD / 32), j0 = (it % (NMOD / 32)) * 32;
            const float* W = a.in[2] + (size_t)l * D * NMOD + j0 + 4 * cg;
            f32x4 acc[4] = {{0.f, 0.f, 0.f, 0.f}, {0.f, 0.f, 0.f, 0.f}, {0.f, 0.f, 0.f, 0.f}, {0.f, 0.f, 0.f, 0.f}};
#pragma unroll 16
            for (int kk = 0; kk < 32; ++kk) { const int k = kg * 32 + kk; const f32x4 w = *(const GAS f32x4*)(W + (size_t)k * NMOD);
#pragma unroll
                for (int b = 0; b < 4; ++b) acc[b] += w * cact[b * D + k]; }
#pragma unroll
            for (int b = 0; b < 4; ++b) *(LAS f32x4*)(red + (kg * 4 + b) * 32 + 4 * cg) = acc[b];
            __syncthreads();
            if (F.tid < 128) { const int b = F.tid >> 5, col = F.tid & 31; float sm = 0.f;
#pragma unroll 16
              for (int q = 0; q < 64; ++q) sm += red[(q * 4 + b) * 32 + col];
              MOD[((size_t)l * NB + b) * NMOD + j0 + col] = sm + a.in[3][(size_t)l * NMOD + j0 + col]; }
            __syncthreads();
        }
    }
    LAS float* scr = (LAS float*)(F.lds + RING_OFF + F.wave * 16384);
    const int gw = F.vcu * NWAVES + F.wave, NGW = F.G * NWAVES;
    constexpr int I_FI = (D / 64) * (2 * FF / 64), I_FO = (FF / 64) * (D / 64), I_WIN = (D / 64) * ((NIN + 63) / 64), I_UP = (1024 / 64) * (D / 64), I_WO = (D / 64) * (D / 64);
    constexpr int PER_L = 2 * I_FI + 2 * I_FO + I_WIN + 2 * I_UP + I_WO;
    LAS unsigned* scu = (LAS unsigned*)scr;
    for (int it = gw; it < DEPTH * PER_L; it += NGW) {
        const int l = it / PER_L; int r = it % PER_L;
        if (r < 2 * I_FI) { const int f = r / I_FI; p0_transpose_item64(a.in[5] + ((size_t)l * 2 + f) * D * 2 * FF, D, 2 * FF, (bf16*)(ws + WS_WFI + ((size_t)l * 2 + f) * SZ_WFI1), MapFfnIn(), scu, r % I_FI, F.lane); continue; } r -= 2 * I_FI;
        if (r < 2 * I_FO) { const int f = r / I_FO; p0_transpose_item64(a.in[6] + ((size_t)l * 2 + f) * FF * D, FF, D, (bf16*)(ws + WS_WFO + ((size_t)l * 2 + f) * SZ_WFO1), MapIdent(), scu, r % I_FO, F.lane); continue; } r -= 2 * I_FO;
        if (r < I_WIN) { p0_transpose_item64(a.in[7] + (size_t)l * D * NIN, D, NIN, (bf16*)(ws + WS_WIN + (size_t)l * SZ_WIN1), MapWin(), scu, r, F.lane); continue; } r -= I_WIN;
        if (r < I_UP) { p0_transpose_item64(a.in[17] + (size_t)l * 1024 * D, 1024, D, (bf16*)(ws + WS_WUPN + (size_t)l * 2 * SZ_WUP1), MapIdent(), scu, r, F.lane, 2048, 0); continue; } r -= I_UP;
        if (r < I_UP) { p0_transpose_item64(a.in[18] + (size_t)l * 1024 * D, 1024, D, (bf16*)(ws + WS_WUPN + (size_t)l * 2 * SZ_WUP1), MapIdent(), scu, r, F.lane, 2048, 1024); continue; } r -= I_UP;
        p0_transpose_item64(a.in[19] + (size_t)l * D * D, D, D, (bf16*)(ws + WS_WOUT + (size_t)l * SZ_WOUT1), MapIdent(), scu, r, F.lane);
    }
    for (int l = 0; l < DEPTH; ++l) { GAS v4u* p = (GAS v4u*)(ws + WS_WIN + (size_t)l * SZ_WIN1 + (size_t)4448 * D * 2);
        for (int i = gw * 64 + F.lane; i < 160 * D * 2 / 16; i += NGW * 64) p[i] = (v4u){0u, 0u, 0u, 0u}; }
    { constexpr int I_C1 = (2048 / 64) * (256 / 32), I_C2 = (256 / 64) * (64 / 32), I_UV = (256 / 64) * (1024 / 32), PER = 2 * I_C1 + 2 * I_C2 + I_UV;
      for (int it = gw; it < DEPTH * PER; it += NGW) { const int l = it / PER; int r = it % PER;
        if (r < 2 * I_C1) { const int kv = r / I_C1; p0_transpose_item(a.in[kv ? 12 : 10] + (size_t)l * 2048 * 256, 2048, 256, (bf16*)(ws + WS_WC1) + ((size_t)l * 512 + kv * 256) * 2048, MapIdent(), scr, r % I_C1, F.lane); continue; } r -= 2 * I_C1;
        if (r < 2 * I_C2) { const int kv = r / I_C2; p0_transpose_item(a.in[kv ? 13 : 11] + (size_t)l * 256 * 64, 256, 64, (bf16*)(ws + WS_WC2) + ((size_t)l * 2 + kv) * 64 * 256, MapIdent(), scr, r % I_C2, F.lane); continue; } r -= 2 * I_C2;
        p0_transpose_item(a.in[16] + (size_t)l * 256 * 1024, 256, 1024, (bf16*)(ws + WS_WUVT) + (size_t)l * 1024 * 256, MapIdent(), scr, r, F.lane); } }
    { const float* src = a.in[15]; bf16* dst = (bf16*)(ws + WS_WUK);
      for (int i = gw * 64 + F.lane; i < DEPTH * 256 * 1024 / 4; i += NGW * 64) { const f32x4 v = *(const GAS f32x4*)(src + 4 * (size_t)i);
          *(GAS unsigned long long*)(dst + 4 * (size_t)i) = (unsigned long long)pk2(v.x, v.y) | ((unsigned long long)pk2(v.z, v.w) << 32); } }
    for (int it = gw; it < DEPTH * 2 * 4; it += NGW) { const int l = it >> 3, kv = (it >> 2) & 1, j = (it & 3) * 64 + F.lane;
        const float* pe = a.in[kv ? 9 : 8] + (size_t)l * 2048; const float* w1 = a.in[kv ? 12 : 10] + (size_t)l * 2048 * 256 + j; float s = 0.f;
        for (int k = 0; k < 2048; ++k) s += pe[k] * w1[(size_t)k * 256];
        ((float*)(ws + WS_B1))[(l * 2 + kv) * 256 + j] = s; }
}

__global__ void __launch_bounds__(NWAVES * 64, 2) mk_fwd(Args args) {
    extern __shared__ __attribute__((aligned(16))) unsigned char lds[];
    Frame F;
    F.lds = (LAS unsigned char*)lds;
    F.MISC = (volatile LAS unsigned*)(F.lds + MISC_OFF);
    F.tid = threadIdx.x; F.lane = F.tid & 63; F.wave = __builtin_amdgcn_readfirstlane(F.tid >> 6);
    F.G = gridDim.x; { const int bx = blockIdx.x; F.vcu = (F.G % 8 == 0) ? (bx % 8) * (F.G / 8) + bx / 8 : bx; }
    unsigned char* ws = args.ws;
    F.ctl = (gu32*)(ws + WS_CTL);
    for (int u = F.tid; u < (LDS_BYTES - LDSCTL_OFF) / 4; u += NWAVES * 64) ((LAS unsigned*)(F.lds + LDSCTL_OFF))[u] = 0u;
    __syncthreads();
    XcdBarrier bar = xcd_barrier_post((unsigned*)(F.ctl + CW_BAR) + args.li * XCD_BAR_WORDS, F.MISC + 8);
    const int lo = args.ph_lo, hi = args.ph_hi;
#define IN(k) (lo <= (k) && (k) < hi)
#define SEAM(k) do { if ((k) + 1 < hi) xcd_barrier(bar, F.wave); } while (0)

    if (IN(0)) { for (int rep = 0; rep < REP_P0; ++rep) { p0_prologue(F, args); if (rep + 1 < REP_P0) __syncthreads(); } SEAM(0); }

    for (int ll = 0; ll < DEPTH * REP_ALL; ++ll) { const int l = ll % DEPTH;
        const int pb = 1 + l * NPL;
        if (PHON(0) && IN(pb + 0)) { unsigned char* w = launder(ws); Frame Fp = refresh(F); const float* xin0 = (l == 0) ? launder(args.in[0]) : (const float*)(w + WS_X);
            for (int rep = 0; rep < REP_MOD; ++rep) modulate_phase(Fp, xin0, (bf16*)(w + WS_H), launder(args.in[4]) + (size_t)l * 3 * D, (const float*)(w + WS_MOD) + (size_t)l * NB * NMOD); SEAM(pb + 0); }
        if (PHON(1) && IN(pb + 1)) { unsigned char* w = launder(ws); Frame Fp = refresh(F);
            pg8::Gemm g{(const bf16*)(w + WS_H), (const bf16*)(w + WS_WFI + ((size_t)l * 2 + 0) * SZ_WFI1), M, 2 * FF, D, D, D}; pg8::StaticOrder S; S.init(M, 2 * FF, Fp.G, (int)blockIdx.x);
            EpiSwiglu E{(bf16*)(w + WS_ACT)};
            for (int rep = 0; rep < REP_FFI; ++rep) pg8::gemm_phase<EpiSwiglu, pg8::StaticOrder, true, true>(Fp.lds + RING_OFF, g, S, E, Fp.wave);
            SEAM(pb + 1);
        }
        if (PHON(2) && IN(pb + 2)) { unsigned char* w = launder(ws); Frame Fp = refresh(F); const float* xin0 = (l == 0) ? launder(args.in[0]) : (const float*)(w + WS_X);
            pg8::Gemm g{(const bf16*)(w + WS_ACT), (const bf16*)(w + WS_WFO + ((size_t)l * 2 + 0) * SZ_WFO1), M, D, FF, FF, FF}; pg8::StaticOrder S; S.init(M, D, Fp.G, (int)blockIdx.x);
            EpiResid E{xin0, (float*)(w + WS_X), (const float*)(w + WS_MOD) + (size_t)l * NB * NMOD + 2 * D, 0.5f};
            for (int rep = 0; rep < (l == 0 ? REP_FFO : 1); ++rep) pg8::gemm_phase<EpiResid, pg8::StaticOrder, true, true>(Fp.lds + RING_OFF, g, S, E, Fp.wave);
            SEAM(pb + 2);
        }
        if (PHON(3) && IN(pb + 3)) { unsigned char* w = launder(ws); Frame Fp = refresh(F);
            for (int rep = 0; rep < REP_MOD; ++rep) modulate_phase(Fp, (const float*)(w + WS_X), (bf16*)(w + WS_H), launder(args.in[4]) + (size_t)l * 3 * D + D, (const float*)(w + WS_MOD) + (size_t)l * NB * NMOD + 3 * D); SEAM(pb + 3); }
        if (PHON(4) && IN(pb + 4)) { unsigned char* w = launder(ws); Frame Fp = refresh(F);
            pg8::Gemm g{(const bf16*)(w + WS_H), (const bf16*)(w + WS_WIN + (size_t)l * SZ_WIN1), M, NINP, D, D, D}; pg8::StaticOrder S; S.init(M, NINP, Fp.G, (int)blockIdx.x);
            EpiWin E{w};
            for (int rep = 0; rep < REP_WIN; ++rep) pg8::gemm_phase<EpiWin, pg8::StaticOrder, true, true>(Fp.lds + RING_OFF, g, S, E, Fp.wave);
            SEAM(pb + 4);
        }
        if (PHON(5) && IN(pb + 5)) { unsigned char* w = launder(ws); Frame Fp = refresh(F);
            const int ncmp = Fp.G > 64 ? 32 : 0;
            if (Fp.vcu < ncmp || ncmp == 0) {
                pg8::Gemm g{(const bf16*)(w + WS_KV), (const bf16*)(w + WS_WC1 + (size_t)l * 512 * 2048 * 2), 8192, 512, 2048, 1024, 2048}; CmpOrder S{ncmp ? ncmp : Fp.G, Fp.vcu};
                EpiCmp1 E{(bf16*)(w + WS_CMPH), (const float*)(w + WS_B1) + l * 512};
                pg8::gemm_phase<EpiCmp1, CmpOrder, true, true>(Fp.lds + RING_OFF, g, S, E, Fp.wave);
                if (ncmp) cmp2_items((const bf16*)(w + WS_CMPH), (const bf16*)(w + WS_WC2) + (size_t)l * 2 * 64 * 256, (bf16*)(w + WS_KCMP), Fp.vcu * 16, Fp.vcu * 16 + 16, Fp.wave, NWAVES, Fp.lane);
            }
            if (Fp.vcu >= ncmp) { const int w0 = (Fp.vcu - ncmp) * NWAVES + Fp.wave, nw = (Fp.G - ncmp) * NWAVES;
                for (int rep = 0; rep < REP_THIN; ++rep) ckvnorm_rows((const float*)(w + WS_CKVR), (bf16*)(w + WS_CKVN), launder(args.in[14]) + l * 256, w0, nw, Fp.lane);
                for (int rep = 0; rep < REP_THIN; ++rep) qlat_items((const bf16*)(w + WS_QD), (const bf16*)(w + WS_WUK) + (size_t)l * 256 * 1024, (bf16*)(w + WS_QLAT), (Fp.vcu - ncmp) >> 1, (Fp.G - ncmp) >> 1, (Fp.vcu - ncmp) & 1, Fp.wave, Fp.lane); }
            SEAM(pb + 5);
        }
        if (PHON(6) && IN(pb + 6) && !(F.G > 64)) { unsigned char* w = launder(ws); Frame Fp = refresh(F);
            for (int kvh = 0; kvh < 2; ++kvh) cmp2_items((const bf16*)(w + WS_CMPH), (const bf16*)(w + WS_WC2) + (size_t)l * 2 * 64 * 256, (bf16*)(w + WS_KCMP), 256 * kvh, 256 * kvh + 256, Fp.vcu * NWAVES + Fp.wave, Fp.G * NWAVES, Fp.lane);
            SEAM(pb + 6);
        }
        if (PHON(7) && IN(pb + 7)) { unsigned char* w = launder(ws); Frame Fp = refresh(F);
            build_luts(Fp, launder(args.in[20]));
            if (Fp.G == 256) {
                const int b = Fp.vcu >> 6, g = (Fp.vcu >> 4) & 3, s = Fp.vcu & 15; int itc = 0;
#pragma unroll 1
                for (int qq = 0; qq < 4 * REP_NSA; ++qq) { const int q = qq & 3; const int i = (q == 0) ? s : (q == 1) ? 31 - s : (q == 2) ? 32 + s : 63 - s;
#ifndef NO_NSA
                    nsa_unit(Fp, b, g, i, (const bf16*)(w + WS_QN), (const bf16*)(w + WS_KV), (const bf16*)(w + WS_KCMP), (const float*)(w + WS_GN), (bf16*)(w + WS_ON), itc);
#endif
                }
                __syncthreads();
                const int j = (Fp.vcu & 63) * NWAVES + Fp.wave;
#pragma unroll 1
                for (int kk = 0; kk < 8 * REP_DSA; ++kk) { const int k = (Fp.wave & 4) ? 7 - (kk & 7) : (kk & 7); const int t = 512 * k + ((k & 1) ? 511 - j : j);
#ifndef NO_DSA
                    dsa_token(Fp, b, t, (const bf16*)(w + WS_QI), (const bf16*)(w + WS_KI), (const float*)(w + WS_WI), (const bf16*)(w + WS_CKVN), (const bf16*)(w + WS_QLAT), (bf16*)(w + WS_OLAT));
#endif
                }
            }
            SEAM(pb + 7);
        }
        if (PHON(8) && IN(pb + 8)) { unsigned char* w = launder(ws); Frame Fp = refresh(F);
            for (int rep = 0; rep < REP_THIN; ++rep) od_items((const bf16*)(w + WS_OLAT), (const bf16*)(w + WS_WUVT) + (size_t)l * 1024 * 256, (bf16*)(w + WS_ON), Fp.vcu, Fp.G, Fp.wave, Fp.lane);
            SEAM(pb + 8);
        }
        if (PHON(9) && IN(pb + 9)) { unsigned char* w = launder(ws); Frame Fp = refresh(F);
            pg8::Gemm g{(const bf16*)(w + WS_ON), (const bf16*)(w + WS_WUPN + (size_t)l * 2 * SZ_WUP1), M, D, 2048, 2048, 2048}; pg8::StaticOrder S; S.init(M, D, Fp.G, (int)blockIdx.x);
            EpiUpF E{(const bf16*)(w + WS_AM), (bf16*)(w + WS_Y)};
            pg8::gemm_phase<EpiUpF, pg8::StaticOrder, true, true>(Fp.lds + RING_OFF, g, S, E, Fp.wave);
            SEAM(pb + 9);
        }
        if (PHON(10) && IN(pb + 10)) { unsigned char* w = launder(ws); Frame Fp = refresh(F);
            pg8::Gemm g{(const bf16*)(w + WS_Y), (const bf16*)(w + WS_WOUT + (size_t)l * SZ_WOUT1), M, D, D, D, D}; pg8::StaticOrder S; S.init(M, D, Fp.G, (int)blockIdx.x);
            EpiResid E{(const float*)(w + WS_X), (float*)(w + WS_X), (const float*)(w + WS_MOD) + (size_t)l * NB * NMOD + 3 * D + 2 * D, 1.0f};
            pg8::gemm_phase<EpiResid, pg8::StaticOrder, true, true>(Fp.lds + RING_OFF, g, S, E, Fp.wave);
            SEAM(pb + 10);
        }
        if (PHON(11) && IN(pb + 11)) { unsigned char* w = launder(ws); Frame Fp = refresh(F);
            for (int rep = 0; rep < REP_MOD; ++rep) modulate_phase(Fp, (const float*)(w + WS_X), (bf16*)(w + WS_H), launder(args.in[4]) + (size_t)l * 3 * D + 2 * D, (const float*)(w + WS_MOD) + (size_t)l * NB * NMOD + 2 * 3 * D); SEAM(pb + 11); }
        if (PHON(12) && IN(pb + 12)) { unsigned char* w = launder(ws); Frame Fp = refresh(F);
            pg8::Gemm g{(const bf16*)(w + WS_H), (const bf16*)(w + WS_WFI + ((size_t)l * 2 + 1) * SZ_WFI1), M, 2 * FF, D, D, D}; pg8::StaticOrder S; S.init(M, 2 * FF, Fp.G, (int)blockIdx.x);
            EpiSwiglu E{(bf16*)(w + WS_ACT)};
            for (int rep = 0; rep < REP_FFI; ++rep) pg8::gemm_phase<EpiSwiglu, pg8::StaticOrder, true, true>(Fp.lds + RING_OFF, g, S, E, Fp.wave);
            SEAM(pb + 12);
        }
        if (PHON(13) && IN(pb + 13)) { unsigned char* w = launder(ws); Frame Fp = refresh(F);
            pg8::Gemm g{(const bf16*)(w + WS_ACT), (const bf16*)(w + WS_WFO + ((size_t)l * 2 + 1) * SZ_WFO1), M, D, FF, FF, FF}; pg8::StaticOrder S; S.init(M, D, Fp.G, (int)blockIdx.x);
            EpiResid E{(const float*)(w + WS_X), (float*)(w + WS_X), (const float*)(w + WS_MOD) + (size_t)l * NB * NMOD + 2 * 3 * D + 2 * D, 0.5f};
            pg8::gemm_phase<EpiResid, pg8::StaticOrder, true, true>(Fp.lds + RING_OFF, g, S, E, Fp.wave);
            SEAM(pb + 13);
        }
    }
    if (IN(NPH - 1)) { unsigned char* w = launder(ws); Frame Fp = refresh(F); final_norm_phase(Fp, (const float*)(w + WS_X), launder(args.out), launder(args.in[21])); }
#undef IN
#undef SEAM
}

extern "C" void kernel_launch(void* const* d_in, const int* in_sizes, int n_in, void* d_out, int out_size, void* d_ws, size_t ws_size, hipStream_t stream) {
    static int grid = 0;
    if (grid == 0) {
        if (n_in != 22 || out_size != M * D || ws_size < WS_END) { fprintf(stderr, "kernel_launch: unexpected shapes (n_in %d, out %d, ws %zu < %zu)\n", n_in, out_size, ws_size, (size_t)WS_END); grid = -1; return; }
        int dev = 0, cus = 0, per_cu = 0;
        if (hipGetDevice(&dev) != hipSuccess || hipDeviceGetAttribute(&cus, hipDeviceAttributeMultiprocessorCount, dev) != hipSuccess) { grid = -1; return; }
        if (hipFuncSetAttribute((const void*)mk_fwd, hipFuncAttributeMaxDynamicSharedMemorySize, LDS_BYTES) != hipSuccess) { fprintf(stderr, "kernel_launch: hipFuncSetAttribute failed\n"); grid = -1; return; }
        if (hipOccupancyMaxActiveBlocksPerMultiprocessor(&per_cu, (const void*)mk_fwd, NWAVES * 64, LDS_BYTES) != hipSuccess || per_cu < 1) fprintf(stderr, "kernel_launch: occupancy query says %d\n", per_cu);
        (void)hipGetLastError();
        grid = cus;
    }
    if (grid < 0) return;
    (void)hipMemsetAsync((char*)d_ws + WS_CTL, 0, CTL_ZERO_BYTES, stream);
    Args a{};
    for (int i = 0; i < 22; ++i) a.in[i] = (const float*)d_in[i];
    a.out = (float*)d_out; a.ws = (unsigned char*)d_ws;
    a.ph_lo = 0; a.ph_hi = NPH; a.li = 0; a.pad = 0;
    hipLaunchKernelGGL(mk_fwd, dim3(grid), dim3(NWAVES * 64), LDS_BYTES, stream, a);
}
```

```cpp
#include <hip/hip_runtime.h>
#include <cstdio>
#include <cstdint>


#ifndef PHM
#define PHM 0xffff
#endif
#define PHON(k) (((PHM) >> (k)) & 1)
#ifndef REP_P0
#define REP_P0 1
#endif
#ifndef REP_FFI
#define REP_FFI 1
#endif
#ifndef REP_FFO
#define REP_FFO 1
#endif
#ifndef REP_WIN
#define REP_WIN 1
#endif
#ifndef REP_UP
#define REP_UP 1
#endif
#ifndef REP_MOD
#define REP_MOD 1
#endif
#ifndef REP_THIN
#define REP_THIN 1
#endif
#ifndef REP_ALL
#define REP_ALL 1
#endif
#ifndef REP_NSA
#define REP_NSA 1
#endif
#ifndef REP_DSA
#define REP_DSA 1
#endif

__device__ __forceinline__ int fresh_lane() { unsigned z = 0u; asm volatile("" : "+v"(z)); return (int)__builtin_amdgcn_mbcnt_hi(~0u, __builtin_amdgcn_mbcnt_lo(~0u, z)); }

namespace pg8 {
#define PG8_LAS __attribute__((address_space(3)))
typedef unsigned short bf16_t;
typedef short bf16x8 __attribute__((ext_vector_type(8)));
typedef float f32x4 __attribute__((ext_vector_type(4)));
typedef float f32x2 __attribute__((ext_vector_type(2)));
typedef unsigned u32x4 __attribute__((ext_vector_type(4)));
typedef unsigned u32x2 __attribute__((ext_vector_type(2)));
constexpr int BM = 256, BK = 64, HALF = 128, HTB = HALF * BK * 2, STAGE_BYTES = 8 * HTB, NXCD = 8, WGM = 8;

__host__ __device__ __forceinline__ int lds_byte(int r, int c) { const int st = (r >> 4) * 2 + (c >> 5), rr = r & 15, cc = c & 31, ob = rr * 64 + cc * 2; return st * 1024 + (ob ^ (((ob >> 9) & 1) << 5)); }
__host__ __device__ __forceinline__ void stage_rc(int b, int& R, int& C) { const int st = b / 1024, sb = b % 1024, swz = sb ^ (((sb >> 9) & 1) << 5); R = (st >> 1) * 16 + swz / 64; C = (st & 1) * 32 + (swz % 64) / 2; }
__host__ __device__ __forceinline__ int perm32(int rho) { const int n = rho >> 4, i = rho & 15; return 8 * (i >> 2) + 4 * n + (i & 3); }

struct Unit { int pm, pn; };
struct Gemm { const bf16_t* A; const bf16_t* Bt; int M, N, K, lda, ldb; };

struct StaticOrder {
    int nM, nN, nwg, G, c;
    __host__ __device__ void init(int M, int N, int G_, int c_) { nM = M / BM; nN = N / BM; nwg = nM * nN; G = G_; c = c_; }
    __host__ __device__ bool next(int i, Unit& u) const {
        const long L = (long)i * G + c; if (L >= nwg) return false;
        int wgid = (int)L; { const int q = nwg / NXCD, r = nwg % NXCD, xcd = wgid % NXCD, off = wgid / NXCD; wgid = (xcd < r ? xcd * (q + 1) : r * (q + 1) + (xcd - r) * q) + off; }
        const int nig = WGM * nN, gid = wgid / nig, fm = gid * WGM, gsz = (nM - fm) < WGM ? (nM - fm) : WGM;
        u.pm = fm + ((wgid % nig) % gsz); u.pn = (wgid % nig) / gsz; return true;
    }
    __device__ __forceinline__ void a_ready(const Unit&) const {}
    __device__ __forceinline__ void done(const Unit&) const {}
};

typedef __bf16 pk_bf2_t __attribute__((ext_vector_type(2)));
typedef float pk_f2_t __attribute__((ext_vector_type(2)));
__device__ __forceinline__ unsigned cvt_pk_bf16(float lo, float hi) { const pk_f2_t v = {lo, hi}; return __builtin_bit_cast(unsigned, __builtin_convertvector(v, pk_bf2_t)); }

template <class Epi, class Sched, bool ALIGN_EPI = false, bool SP2 = false>
__device__ __forceinline__ void gemm_phase(PG8_LAS unsigned char* lds, const Gemm g, const Sched& S, const Epi& E, int wave_s) {
    int tid_ = (wave_s << 6) | fresh_lane(); asm volatile("" : "+v"(tid_));
    const int tid = tid_, wid = __builtin_amdgcn_readfirstlane(tid >> 6), lane = tid & 63, wr = wid >> 2, wc = wid & 3, fr = lane & 15, fq = lane >> 4;
    const int K = g.K, nt = K / BK;
    unsigned voffA[2], voffB[2];
#pragma unroll
    for (int i = 0; i < 2; ++i) { int R, C; stage_rc(tid * 16 + i * 8192, R, C); const int Rb = Epi::PERM ? ((R & ~31) + perm32(R & 31)) : R;
        voffA[i] = (unsigned)(R * g.lda + C) * 2u; voffB[i] = (unsigned)(Rb * g.ldb + C) * 2u; }
    const size_t kstep = (size_t)(BK * 2);
    const size_t hstepA = (size_t)HALF * g.lda * 2, hstepB = (size_t)HALF * g.ldb * 2;
    const size_t tstepA = 2 * hstepA, tstepB = 2 * hstepB;
    const unsigned ldsw = (unsigned)wid * 1024u;
    const int aoff = lds_byte(wr * 64 + fr, fq * 8), boff = lds_byte(wc * 32 + fr, fq * 8);
#define PG8_SA(b, h) (((b) * 2 + (h)) * HTB)
#define PG8_SB(b, h) ((4 + (b) * 2 + (h)) * HTB)
#define PG8_STAGE(bufoff, gbase, voff) do { _Pragma("unroll") for (int _i = 0; _i < 2; ++_i) \
        __builtin_amdgcn_global_load_lds((const unsigned*)((const char*)(gbase) + (voff)[_i]), (PG8_LAS unsigned*)(lds + (bufoff) + ldsw + _i * 8192), 16, 0, 0); } while (0)
#define PG8_LDA(dst, b, h) do { _Pragma("unroll") for (int m = 0; m < 4; ++m) _Pragma("unroll") for (int k = 0; k < 2; ++k) dst[m][k] = *(const PG8_LAS bf16x8*)(lds + PG8_SA(b, h) + aoff + m * 2048 + k * 1024); } while (0)
#define PG8_LDB(dst, b, h) do { _Pragma("unroll") for (int n = 0; n < 2; ++n) _Pragma("unroll") for (int k = 0; k < 2; ++k) dst[n][k] = *(const PG8_LAS bf16x8*)(lds + PG8_SB(b, h) + boff + n * 2048 + k * 1024); } while (0)
#define PG8_MMA(ai, bj, At, Bt) do { __builtin_amdgcn_s_setprio(1); _Pragma("unroll") for (int m = 0; m < 4; ++m) _Pragma("unroll") for (int n = 0; n < 2; ++n) _Pragma("unroll") for (int k = 0; k < 2; ++k) \
        acc[ai][bj][m][n] = __builtin_amdgcn_mfma_f32_16x16x32_bf16(Bt[n][k], At[m][k], acc[ai][bj][m][n], 0, 0, 0); __builtin_amdgcn_s_setprio(0); } while (0)
#define PG8_WAIT_V(n) asm volatile("s_waitcnt vmcnt(" #n ")" ::: "memory")
#define PG8_WAIT_L(n) asm volatile("s_waitcnt lgkmcnt(" #n ")" ::: "memory")
#define PG8_BAR __builtin_amdgcn_s_barrier()
#define PG8_SCHED __builtin_amdgcn_sched_barrier(0)
    Unit cur, nxt; int ui = 0;
    if (!S.next(0, cur)) return;
    f32x4 acc[2][2][4][2];
#pragma unroll
    for (int a = 0; a < 2; ++a)
#pragma unroll
        for (int b = 0; b < 2; ++b)
#pragma unroll
            for (int m = 0; m < 4; ++m)
#pragma unroll
                for (int n = 0; n < 2; ++n) acc[a][b][m][n] = (f32x4){0.f, 0.f, 0.f, 0.f};
    bf16x8 At[4][2], B0[2][2], B1[2][2];
    const char* cA = (const char*)g.A + (size_t)cur.pm * tstepA; const char* cB = (const char*)g.Bt + (size_t)cur.pn * tstepB;
    S.a_ready(cur);
    if constexpr (SP2) {
        PG8_STAGE(PG8_SB(0, 0), cB, voffB); PG8_STAGE(PG8_SB(0, 1), cB + hstepB, voffB); PG8_STAGE(PG8_SA(0, 0), cA, voffA); PG8_STAGE(PG8_SA(0, 1), cA + hstepA, voffA);
        if (wr == 1) PG8_BAR;
        PG8_WAIT_V(2); PG8_BAR;
        PG8_STAGE(PG8_SB(1, 0), cB + kstep, voffB); PG8_STAGE(PG8_SA(1, 0), cA + kstep, voffA); PG8_STAGE(PG8_SB(1, 1), cB + hstepB + kstep, voffB);
        PG8_WAIT_V(6); PG8_BAR;
    } else {
        PG8_STAGE(PG8_SB(0, 0), cB, voffB); PG8_STAGE(PG8_SA(0, 0), cA, voffA); PG8_STAGE(PG8_SB(0, 1), cB + hstepB, voffB); PG8_STAGE(PG8_SA(0, 1), cA + hstepA, voffA);
        if (wr == 1) PG8_BAR;
        PG8_WAIT_V(4); PG8_BAR;
        PG8_STAGE(PG8_SB(1, 0), cB + kstep, voffB); PG8_STAGE(PG8_SA(1, 0), cA + kstep, voffA); PG8_STAGE(PG8_SB(1, 1), cB + hstepB + kstep, voffB);
        PG8_WAIT_V(6); PG8_BAR;
    }
    for (;;) {
        const bool has_next = S.next(ui + 1, nxt);
        const char* nA = has_next ? (const char*)g.A + (size_t)nxt.pm * tstepA : cA; const char* nB = has_next ? (const char*)g.Bt + (size_t)nxt.pn * tstepB : cB;
        for (int t = 0; t < nt; t += 2) {
            const bool last = (t == nt - 2);
            const char* a1 = cA + (size_t)(t + 1) * kstep;
            const char* a2 = last ? nA : cA + (size_t)(t + 2) * kstep; const char* b2 = last ? nB : cB + (size_t)(t + 2) * kstep;
            const char* a3 = a2 + kstep; const char* b3 = b2 + kstep;
            if (last && has_next) S.a_ready(nxt);
            if constexpr (Epi::HAS_MID) { if (t == nt / 2) E.mid(acc, cur, wr, wc, fr, fq); }
            if constexpr (SP2) {
            PG8_LDB(B0, 0, 0); PG8_LDB(B1, 0, 1); PG8_SCHED; PG8_LDA(At, 0, 0); PG8_STAGE(PG8_SA(1, 1), a1 + hstepA, voffA);
            PG8_WAIT_V(8); PG8_WAIT_L(0); PG8_BAR; PG8_MMA(0, 0, At, B0); PG8_MMA(0, 1, At, B1); PG8_BAR; PG8_SCHED;
            PG8_LDA(At, 0, 1); PG8_STAGE(PG8_SB(0, 0), b2, voffB); PG8_STAGE(PG8_SB(0, 1), b2 + hstepB, voffB); PG8_STAGE(PG8_SA(0, 0), a2, voffA);
            PG8_WAIT_V(8); PG8_WAIT_L(0); PG8_BAR; PG8_MMA(1, 0, At, B0); PG8_MMA(1, 1, At, B1); PG8_BAR; PG8_SCHED;
            PG8_LDB(B0, 1, 0); PG8_LDB(B1, 1, 1); PG8_SCHED; PG8_LDA(At, 1, 0); PG8_STAGE(PG8_SA(0, 1), a2 + hstepA, voffA);
            PG8_WAIT_V(8); PG8_WAIT_L(0); PG8_BAR; PG8_MMA(0, 0, At, B0); PG8_MMA(0, 1, At, B1); PG8_BAR; PG8_SCHED;
            PG8_LDA(At, 1, 1); PG8_STAGE(PG8_SB(1, 0), b3, voffB); PG8_STAGE(PG8_SB(1, 1), b3 + hstepB, voffB); PG8_STAGE(PG8_SA(1, 0), a3, voffA);
            PG8_WAIT_V(8); PG8_WAIT_L(0); PG8_BAR; PG8_MMA(1, 0, At, B0); PG8_MMA(1, 1, At, B1); PG8_BAR; PG8_SCHED;
            } else {
            PG8_LDB(B0, 0, 0); PG8_SCHED; PG8_LDA(At, 0, 0); PG8_STAGE(PG8_SA(1, 1), a1 + hstepA, voffA);
            PG8_WAIT_L(8); PG8_BAR; PG8_WAIT_L(0); PG8_MMA(0, 0, At, B0); PG8_BAR; PG8_SCHED;
            PG8_LDB(B1, 0, 1); PG8_STAGE(PG8_SB(0, 0), b2, voffB);
            PG8_BAR; PG8_WAIT_L(0); PG8_MMA(0, 1, At, B1); PG8_BAR;
            PG8_LDA(At, 0, 1); PG8_STAGE(PG8_SA(0, 0), a2, voffA);
            PG8_BAR; PG8_WAIT_L(0); PG8_MMA(1, 0, At, B0); PG8_BAR; PG8_SCHED;
            PG8_STAGE(PG8_SB(0, 1), b2 + hstepB, voffB);
            PG8_WAIT_V(6); PG8_BAR; PG8_MMA(1, 1, At, B1); PG8_BAR;
            PG8_LDB(B0, 1, 0); PG8_SCHED; PG8_LDA(At, 1, 0); PG8_STAGE(PG8_SA(0, 1), a2 + hstepA, voffA);
            PG8_WAIT_L(8); PG8_BAR; PG8_WAIT_L(0); PG8_MMA(0, 0, At, B0); PG8_BAR; PG8_SCHED;
            PG8_LDB(B1, 1, 1); PG8_STAGE(PG8_SB(1, 0), b3, voffB);
            PG8_BAR; PG8_WAIT_L(0); PG8_MMA(0, 1, At, B1); PG8_BAR;
            PG8_LDA(At, 1, 1); PG8_STAGE(PG8_SA(1, 0), a3, voffA);
            PG8_BAR; PG8_WAIT_L(0); PG8_MMA(1, 0, At, B0); PG8_BAR; PG8_SCHED;
            PG8_STAGE(PG8_SB(1, 1), b3 + hstepB, voffB);
            PG8_WAIT_V(6); PG8_BAR; PG8_MMA(1, 1, At, B1); PG8_BAR;
            }
        }
        if constexpr (ALIGN_EPI) { if (wr == 0) PG8_BAR; }
        E(acc, cur, wr, wc, fr, fq); S.done(cur);
        if (!has_next) break;
#pragma unroll
        for (int a = 0; a < 2; ++a)
#pragma unroll
            for (int b = 0; b < 2; ++b)
#pragma unroll
                for (int m = 0; m < 4; ++m)
#pragma unroll
                    for (int n = 0; n < 2; ++n) acc[a][b][m][n] = (f32x4){0.f, 0.f, 0.f, 0.f};
        cur = nxt; cA = nA; cB = nB; ++ui;
        if constexpr (ALIGN_EPI) { if (wr == 1) PG8_BAR; }
    }
    PG8_WAIT_V(0);
    if constexpr (!ALIGN_EPI) { if (wr == 0) PG8_BAR; }
    PG8_BAR;
#undef PG8_SA
#undef PG8_SB
#undef PG8_STAGE
#undef PG8_LDA
#undef PG8_LDB
#undef PG8_MMA
#undef PG8_WAIT_V
#undef PG8_WAIT_L
#undef PG8_BAR
#undef PG8_SCHED
}
}

constexpr int NB = 4, SEQ = 4096, M = NB * SEQ, D = 2048, FF = 5632, NIN = 8544, NINP = 8704, DEPTH = 2, NMOD = 9 * D;
constexpr int NWAVES = 8;
constexpr float RMS_EPS = 1e-6f;
constexpr int NPL = 14;
constexpr int NPH = 1 + DEPTH * NPL + 1;

constexpr size_t MiB = 1u << 20;
constexpr size_t al4k(size_t x) { return (x + 4095) & ~(size_t)4095; }
constexpr size_t WS_CTL = 0, CTL_ZERO_BYTES = 1 * MiB;
constexpr size_t WS_MOD = 1 * MiB;
constexpr size_t WS_WFI = WS_MOD + al4k((size_t)DEPTH * NB * NMOD * 4);
constexpr size_t SZ_WFI1 = (size_t)2 * FF * D * 2;
constexpr size_t WS_WFO = WS_WFI + 4 * SZ_WFI1;
constexpr size_t SZ_WFO1 = (size_t)D * FF * 2;
constexpr size_t WS_WIN = WS_WFO + 4 * SZ_WFO1;
constexpr size_t SZ_WIN1 = (size_t)NINP * D * 2;
constexpr size_t WS_WUPN = WS_WIN + 2 * SZ_WIN1;
constexpr size_t SZ_WUP1 = (size_t)D * 1024 * 2;
constexpr size_t WS_WUPD = WS_WUPN + 2 * SZ_WUP1;
constexpr size_t WS_WOUT = WS_WUPD + 2 * SZ_WUP1;
constexpr size_t SZ_WOUT1 = (size_t)D * D * 2;
constexpr size_t WS_X = WS_WOUT + 2 * SZ_WOUT1;
constexpr size_t WS_H = WS_X + (size_t)M * D * 4;
constexpr size_t WS_ACT = WS_H + (size_t)M * D * 2;
constexpr size_t SZ_QN = (size_t)M * 1024 * 2, SZ_KV1 = (size_t)M * 256 * 2;
constexpr size_t WS_QN = WS_ACT + (size_t)M * FF * 2;
constexpr size_t WS_KV = WS_QN + SZ_QN;
constexpr size_t WS_QD = WS_KV + 6 * SZ_KV1 + 65536;
constexpr size_t WS_CKVR = WS_QD + SZ_QN;
constexpr size_t WS_CKVN = WS_CKVR + (size_t)M * 256 * 4;
constexpr size_t WS_QI = WS_CKVN + (size_t)M * 256 * 2;
constexpr size_t WS_KI = WS_QI + (size_t)M * 512 * 2;
constexpr size_t WS_WI = WS_KI + (size_t)M * 32 * 2;
constexpr size_t WS_GN = WS_WI + (size_t)M * 16 * 4;
constexpr size_t WS_AM = WS_GN + (size_t)M * 48 * 4;
constexpr size_t WS_QLAT = WS_AM + (size_t)M * 4096 * 2;
constexpr size_t WS_OLAT = WS_QLAT + (size_t)M * 4096 * 2;
constexpr size_t WS_CMPH = WS_OLAT + (size_t)M * 4096 * 2;
constexpr size_t WS_KCMP = WS_CMPH + (size_t)2 * 4096 * 256 * 2;
constexpr size_t WS_ON = WS_KCMP + (size_t)2 * 16 * 256 * 64 * 2;
constexpr size_t WS_OD = WS_ON + SZ_QN;
constexpr size_t WS_WC1 = WS_OD + SZ_QN;
constexpr size_t WS_WC2 = WS_WC1 + (size_t)DEPTH * 512 * 2048 * 2;
constexpr size_t WS_B1 = WS_WC2 + (size_t)DEPTH * 2 * 64 * 256 * 2;
constexpr size_t WS_WUK = WS_B1 + 4096;
constexpr size_t WS_WUVT = WS_WUK + (size_t)DEPTH * 256 * 1024 * 2;
constexpr size_t WS_END = WS_WUVT + (size_t)DEPTH * 1024 * 256 * 2;
constexpr size_t WS_YT = WS_ACT;
constexpr size_t WS_Y = WS_H;
constexpr float QSCALE = 0.125f * 1.4426950408889634f, LOG2E = 1.4426950408889634f, INDEX_SCALE = 0.04419417382415922f;

constexpr int CW_TMO = 0, CW_CODE = 1;
constexpr int CW_BAR = 4096;

constexpr int RING_OFF = 0, RING_BYTES = 131072;
constexpr int LDSCTL_OFF = RING_BYTES, MISC_OFF = LDSCTL_OFF + 320;
constexpr int EXTRA_OFF = 132096;
constexpr int LDS_BYTES = 163840;

#define GAS __attribute__((address_space(1)))
#define LAS __attribute__((address_space(3)))
typedef unsigned short bf16;
typedef unsigned v4u __attribute__((ext_vector_type(4)));
typedef float f32x4 __attribute__((ext_vector_type(4)));
typedef short bf16x8 __attribute__((ext_vector_type(8)));
typedef GAS unsigned gu32;
#define RLX_AGENT __ATOMIC_RELAXED, __HIP_MEMORY_SCOPE_AGENT
#define LDS_WAIT() asm volatile("s_waitcnt lgkmcnt(0)" ::: "memory")
#define VM_WAIT() asm volatile("s_waitcnt vmcnt(0)" ::: "memory")
__device__ __forceinline__ unsigned f2bf(float f) { unsigned u = __builtin_bit_cast(unsigned, f); return (u + 0x7fffu + ((u >> 16) & 1u)) >> 16; }
__device__ __forceinline__ unsigned pk2(float lo, float hi) { return f2bf(lo) | (f2bf(hi) << 16); }
typedef __bf16 hbf2 __attribute__((ext_vector_type(2)));
typedef float hf2 __attribute__((ext_vector_type(2)));
__device__ __forceinline__ unsigned cvtpk(float lo, float hi) { const hf2 v = {lo, hi}; return __builtin_bit_cast(unsigned, __builtin_convertvector(v, hbf2)); }
template <class T> __device__ __forceinline__ T* launder(T* p) { asm volatile("" : "+s"(p)); return p; }

#define XB_TMO      128
#define XB_XCNT(j)  (256  + 64 * (j))
#define XB_XSUB(j)  (1280 + 64 * (j))
#define XB_XGEN(j)  (2304 + 64 * (j))
#define XB_TOP      3328
#define XB_TOPGEN   3392
#define XCD_BAR_WORDS 3456
#define XB_SPIN_CAP (1u << 25)

__device__ __forceinline__ unsigned xb_ld(unsigned* p)              { return __hip_atomic_load(p, __ATOMIC_RELAXED, __HIP_MEMORY_SCOPE_AGENT); }
__device__ __forceinline__ unsigned xb_add(unsigned* p, unsigned v) { return __hip_atomic_fetch_add(p, v, __ATOMIC_RELAXED, __HIP_MEMORY_SCOPE_AGENT); }
__device__ __forceinline__ unsigned xb_xcc_id() { return (unsigned)__builtin_amdgcn_s_getreg((3 << 11) | 20) & 0xFu; }
#define XB_SPIN(cond, bar) do { unsigned _sp = 0; while (cond) { __builtin_amdgcn_s_sleep(1); \
    if ((++_sp & 255u) == 0u) { if (xb_ld(&(bar)[XB_TMO])) break; if (_sp > XB_SPIN_CAP) { atomicAdd(&(bar)[XB_TMO], 1u); break; } } } } while (0)

struct XcdBarrier { unsigned* bar; unsigned x; volatile LAS unsigned* st; };

__device__ __forceinline__ XcdBarrier xcd_barrier_post(unsigned* bar, volatile LAS unsigned* st) {
    XcdBarrier b; b.bar = bar; b.x = xb_xcc_id(); b.st = st;
    if (threadIdx.x == 0) (void)xb_add(&bar[XB_XCNT(b.x)], 1u);
    return b;
}
__device__ __forceinline__ void xcd_barrier_complete(unsigned* bar, unsigned x, unsigned& nloc, unsigned& nx) {
    const unsigned G = gridDim.x * gridDim.y * gridDim.z;
    unsigned sum, cnt, mine, sp = 0u;
    for (;;) {
        sum = 0u; cnt = 0u; mine = 0u;
#pragma unroll
        for (unsigned j = 0; j < 16; ++j) { const unsigned c = xb_ld(&bar[XB_XCNT(j)]); sum += c; cnt += (c > 0u) ? 1u : 0u; mine = (j == x) ? c : mine; }
        if (sum == G) break;
        __builtin_amdgcn_s_sleep(1);
        if ((++sp & 255u) == 0u) { if (xb_ld(&bar[XB_TMO])) break; if (sp > XB_SPIN_CAP) { atomicAdd(&bar[XB_TMO], 1u); break; } }
    }
    nloc = mine > 0u ? mine : 1u; nx = cnt > 0u ? cnt : 1u;
}
__device__ __forceinline__ void xcd_barrier(const XcdBarrier& b, int wave_s) {
    asm volatile("s_waitcnt vmcnt(0)" ::: "memory");
    __syncthreads();
    if (wave_s == 0 && fresh_lane() == 0) {
        unsigned* bar = b.bar; asm volatile("" : "+s"(bar));
        __builtin_amdgcn_s_waitcnt(0);
        unsigned nloc = b.st[0], nx = b.st[1];
        if (nloc == 0u) { xcd_barrier_complete(bar, b.x, nloc, nx); b.st[0] = nloc; b.st[1] = nx; }
        const unsigned old = xb_add(&bar[XB_XSUB(b.x)], 1u);
        const unsigned gen = old / nloc;
        if (old + 1u == (gen + 1u) * nloc) {
            __builtin_amdgcn_fence(__ATOMIC_RELEASE, "agent");
            asm volatile("s_waitcnt vmcnt(0)" ::: "memory");
            const unsigned og = xb_add(&bar[XB_TOP], 1u);
            const unsigned tg = og / nx;
            if (og + 1u == (tg + 1u) * nx) xb_add(&bar[XB_TOPGEN], 1u);
            else XB_SPIN(xb_ld(&bar[XB_TOPGEN]) == tg, bar);
            __builtin_amdgcn_fence(__ATOMIC_ACQUIRE, "agent");
            xb_add(&bar[XB_XGEN(b.x)], 1u);
            asm volatile("s_waitcnt vmcnt(0)" ::: "memory");
        } else {
            XB_SPIN(xb_ld(&bar[XB_XGEN(b.x)]) == gen, bar);
            __builtin_amdgcn_fence(__ATOMIC_ACQUIRE, "agent");
            asm volatile("s_waitcnt vmcnt(0)" ::: "memory");
        }
    }
    __syncthreads();
}

struct Frame {
    LAS unsigned char* lds;
    volatile LAS unsigned* MISC;
    gu32* ctl;
    int tid, lane, wave;
    int vcu, G;
};

__device__ __forceinline__ Frame refresh(const Frame& F0) { Frame F = F0; int t = (F0.wave << 6) | fresh_lane(); asm volatile("" : "+v"(t)); F.tid = t; F.lane = t & 63; F.wave = __builtin_amdgcn_readfirstlane(t >> 6); return F; }
template <int X> __device__ __forceinline__ float swz(float v) { return __builtin_bit_cast(float, __builtin_amdgcn_ds_swizzle(__builtin_bit_cast(int, v), (X << 10) | 0x1f)); }
struct SwapPair { unsigned a, b; };
__device__ __forceinline__ SwapPair swap32(float v) { unsigned a = __builtin_bit_cast(unsigned, v), b = a; asm volatile("" : "+v"(b)); auto r = __builtin_amdgcn_permlane32_swap(a, b, false, false); return SwapPair{r[0], r[1]}; }
__device__ __forceinline__ SwapPair swap32p(float x, float y) { unsigned a = __builtin_bit_cast(unsigned, x), b = __builtin_bit_cast(unsigned, y); asm volatile("" : "+v"(a), "+v"(b)); auto r = __builtin_amdgcn_permlane32_swap(a, b, false, false); return SwapPair{r[0], r[1]}; }
__device__ __forceinline__ SwapPair swap16p(float x, float y) { unsigned a = __builtin_bit_cast(unsigned, x), b = __builtin_bit_cast(unsigned, y); asm volatile("" : "+v"(a), "+v"(b)); auto r = __builtin_amdgcn_permlane16_swap(a, b, false, false); return SwapPair{r[0], r[1]}; }
__device__ __forceinline__ float xsum32(float v) { const SwapPair r = swap32(v); return __builtin_bit_cast(float, r.a) + __builtin_bit_cast(float, r.b); }
__device__ __forceinline__ float xmax32(float v) { const SwapPair r = swap32(v); return fmaxf(__builtin_bit_cast(float, r.a), __builtin_bit_cast(float, r.b)); }
__device__ __forceinline__ float xget32(float v, bool upper) { const SwapPair r = swap32(v); return __builtin_bit_cast(float, upper ? r.a : r.b); }
__device__ __forceinline__ SwapPair swap16(float v) { unsigned a = __builtin_bit_cast(unsigned, v), b = a; asm volatile("" : "+v"(b)); auto r = __builtin_amdgcn_permlane16_swap(a, b, false, false); return SwapPair{r[0], r[1]}; }
__device__ __forceinline__ float xsum16(float v) { const SwapPair r = swap16(v); return __builtin_bit_cast(float, r.a) + __builtin_bit_cast(float, r.b); }
__device__ __forceinline__ float xmax16(float v) { const SwapPair r = swap16(v); return fmaxf(__builtin_bit_cast(float, r.a), __builtin_bit_cast(float, r.b)); }
__device__ __forceinline__ float xget16(float v, bool oddrow) { const SwapPair r = swap16(v); return __builtin_bit_cast(float, oddrow ? r.a : r.b); }
__device__ __forceinline__ int wave_total_i(int v) {
    v += __builtin_amdgcn_update_dpp(0, v, 0xB1, 0xf, 0xf, true);
    v += __builtin_amdgcn_update_dpp(0, v, 0x4E, 0xf, 0xf, true);
    v += __builtin_amdgcn_update_dpp(0, v, 0x141, 0xf, 0xf, true);
    v += __builtin_amdgcn_update_dpp(0, v, 0x140, 0xf, 0xf, true);
    return (__builtin_amdgcn_readlane(v, 0) + __builtin_amdgcn_readlane(v, 16)) + (__builtin_amdgcn_readlane(v, 32) + __builtin_amdgcn_readlane(v, 48));
}
__device__ __forceinline__ float wave_sum(float v) {
    v += swz<1>(v); v += swz<2>(v); v += swz<4>(v); v += swz<8>(v); v += swz<16>(v);
    return xsum32(v);
}
__device__ __forceinline__ float silu_f(float g) { return g * __builtin_amdgcn_rcpf(1.0f + __builtin_amdgcn_exp2f(-1.4426950408889634f * g)); }
__device__ __forceinline__ float sigmoid_f(float g) { return __builtin_amdgcn_rcpf(1.0f + __builtin_amdgcn_exp2f(-1.4426950408889634f * g)); }

struct MapIdent { __device__ __forceinline__ int operator()(int n) const { return n; } };
struct MapFfnIn {
    __device__ __forceinline__ int operator()(int n) const { const int isu = n >= FF, c = isu ? n - FF : n; return (c >> 7) * 256 + isu * 128 + (c & 127); } };
struct MapWin {
    __device__ __forceinline__ int operator()(int n) const { return n < 2560 ? n : (n < 2608 ? n + 1840 : (n < 4448 ? n - 48 : n + 160)); } };
template <class Map>
__device__ __forceinline__ void p0_transpose_item(const float* W, int K, int N, bf16* WT, const Map& mp, LAS float* scr, int item, int lane, int ldk = 0, int koff = 0) {
    if (ldk == 0) ldk = K;
    const int nblk = N / 32, kb = item / nblk, nb = item % nblk, k0 = 64 * kb, n0 = 32 * nb;
    float tv[32];
    { const GAS float* wp = (const GAS float*)(W + (size_t)(k0 + (lane >> 5)) * N + n0 + (lane & 31));
#pragma unroll
      for (int i = 0; i < 32; ++i) tv[i] = wp[(size_t)(2 * i) * N]; }
#pragma unroll
    for (int i = 0; i < 32; ++i) scr[(2 * i + (lane >> 5)) * 33 + (lane & 31)] = tv[i];
    LDS_WAIT(); asm volatile("" ::: "memory");
    const int c = lane & 7;
#pragma unroll
    for (int j = 0; j < 4; ++j) { const int n = (lane >> 3) + 8 * j; const LAS float* s = scr + (8 * c) * 33 + n;
        v4u o; o.x = pk2(s[0 * 33], s[1 * 33]); o.y = pk2(s[2 * 33], s[3 * 33]); o.z = pk2(s[4 * 33], s[5 * 33]); o.w = pk2(s[6 * 33], s[7 * 33]);
        *(GAS v4u*)(WT + (size_t)mp(n0 + n) * ldk + koff + k0 + 8 * c) = o; }
    LDS_WAIT(); asm volatile("" ::: "memory");
}
template <class Map>
__device__ __forceinline__ void p0_transpose_item64(const float* W, int K, int N, bf16* WT, const Map& mp, LAS unsigned* scr, int item, int lane, int ldk = 0, int koff = 0) {
    if (ldk == 0) ldk = K;
    const int nblk = (N + 63) / 64, kb = item / nblk, nb = item % nblk, k0 = 64 * kb, n0 = 64 * nb;
    const bool ok = n0 + lane < N;
    float tv[64];
    { const GAS float* wp = (const GAS float*)(W + (size_t)k0 * N + n0 + (ok ? lane : 0));
#pragma unroll
      for (int i = 0; i < 64; ++i) tv[i] = wp[(size_t)i * N]; }
#pragma unroll
    for (int j = 0; j < 32; ++j) scr[j * 65 + lane] = pg8::cvt_pk_bf16(tv[2 * j], tv[2 * j + 1]);
    LDS_WAIT(); asm volatile("" ::: "memory");
    const int c = lane & 7;
#pragma unroll
    for (int jj = 0; jj < 8; ++jj) { const int n = (lane >> 3) + 8 * jj; const LAS unsigned* q = scr + (4 * c) * 65 + n;
        v4u o; o.x = q[0]; o.y = q[65]; o.z = q[130]; o.w = q[195];
        if (n0 + n < N) *(GAS v4u*)(WT + (size_t)mp(n0 + n) * ldk + koff + k0 + 8 * c) = o; }
    LDS_WAIT(); asm volatile("" ::: "memory");
}

struct Args { const float* in[22]; float* out; unsigned char* ws; int ph_lo, ph_hi, li, pad; };

struct EpiSwiglu {
    static constexpr bool PERM = true; static constexpr bool HAS_MID = false;
    bf16* O;
    __device__ __forceinline__ void operator()(const pg8::f32x4 (&acc)[2][2][4][2], const pg8::Unit& u, int wr, int wc, int fr, int fq) const {
        const int row0 = u.pm * 256 + wr * 64 + fr, col0 = u.pn * 128 + wc * 32 + 8 * fq;
        bf16* base = O + (size_t)row0 * FF + col0;
#pragma unroll
        for (int ai = 0; ai < 2; ++ai)
#pragma unroll
            for (int m = 0; m < 4; ++m) {
                pg8::u32x4 w;
                { const pg8::f32x4 g = acc[ai][0][m][0], uu = acc[ai][1][m][0];
                  w.x = pg8::cvt_pk_bf16(silu_f(g[0]) * uu[0], silu_f(g[1]) * uu[1]); w.y = pg8::cvt_pk_bf16(silu_f(g[2]) * uu[2], silu_f(g[3]) * uu[3]); }
                { const pg8::f32x4 g = acc[ai][0][m][1], uu = acc[ai][1][m][1];
                  w.z = pg8::cvt_pk_bf16(silu_f(g[0]) * uu[0], silu_f(g[1]) * uu[1]); w.w = pg8::cvt_pk_bf16(silu_f(g[2]) * uu[2], silu_f(g[3]) * uu[3]); }
                *(pg8::u32x4*)(base + (size_t)(ai * 128 + m * 16) * FF) = w;
                asm volatile("" ::: "memory");
            }
    }
};
struct EpiResid {
    static constexpr bool PERM = false; static constexpr bool HAS_MID = false;
    const float* xin; float* xout; const float* gate;
    float coef;
    __device__ __forceinline__ void operator()(const pg8::f32x4 (&acc)[2][2][4][2], const pg8::Unit& u, int wr, int wc, int fr, int fq) const {
        const int b = u.pm >> 4;
        const int row0 = u.pm * 256 + wr * 64 + fr, col0 = u.pn * 256 + wc * 32 + 4 * fq;
        pg8::f32x4 gv[2][2];
#pragma unroll
        for (int bj = 0; bj < 2; ++bj)
#pragma unroll
            for (int n = 0; n < 2; ++n) gv[bj][n] = *(const pg8::f32x4*)(gate + (size_t)b * NMOD + col0 + bj * 128 + n * 16) * coef;
#pragma unroll
        for (int ai = 0; ai < 2; ++ai)
#pragma unroll
            for (int m = 0; m < 4; ++m) { const size_t off = (size_t)(row0 + ai * 128 + m * 16) * D + col0;
#pragma unroll
                for (int bj = 0; bj < 2; ++bj)
#pragma unroll
                    for (int n = 0; n < 2; ++n) { const pg8::f32x4 xv = *(const pg8::f32x4*)(xin + off + bj * 128 + n * 16);
                        *(pg8::f32x4*)(xout + off + bj * 128 + n * 16) = xv + gv[bj][n] * acc[ai][bj][m][n]; }
                if (m & 1) asm volatile("" ::: "memory"); }
    }
};

__device__ __forceinline__ void modulate_phase(Frame& F, const float* x, bf16* H, const float* gnorm, const float* modsub) {
    const int gw = F.vcu * NWAVES + F.wave, NGW = F.G * NWAVES, per = (M + NGW - 1) / NGW;
    const int rbeg = gw * per, rend = min(rbeg + per, M);
    if (rbeg >= rend) return;
    f32x4 gs[8], sh[8]; int curb = -1;
    f32x4 v[8], nv[8];
    { const GAS f32x4* xr = (const GAS f32x4*)(x + (size_t)rbeg * D) + F.lane;
#pragma unroll
      for (int j = 0; j < 8; ++j) v[j] = xr[64 * j]; }
#pragma unroll 1
    for (int r = rbeg; r < rend; ++r) {
        { const GAS f32x4* xn = (const GAS f32x4*)(x + (size_t)min(r + 1, rend - 1) * D) + F.lane;
#pragma unroll
          for (int j = 0; j < 8; ++j) nv[j] = xn[64 * j]; }
        const int b = r >> 12;
        if (b != curb) { curb = b;
#pragma unroll
            for (int j = 0; j < 8; ++j) { const int c = 4 * F.lane + 256 * j;
                const f32x4 g = *(const GAS f32x4*)(gnorm + c), sc = *(const GAS f32x4*)(modsub + (size_t)b * NMOD + D + c);
                gs[j] = g * (sc + 1.0f); sh[j] = *(const GAS f32x4*)(modsub + (size_t)b * NMOD + c); } }
        float s = 0.f;
#pragma unroll
        for (int j = 0; j < 8; ++j) s += (v[j].x * v[j].x + v[j].y * v[j].y) + (v[j].z * v[j].z + v[j].w * v[j].w);
        const float rstd = 1.0f / sqrtf(wave_sum(s) * (1.0f / D) + RMS_EPS);
        GAS unsigned long long* o8 = (GAS unsigned long long*)(H + (size_t)r * D) + F.lane;
#pragma unroll
        for (int j = 0; j < 8; ++j) { const f32x4 y = v[j] * rstd * gs[j] + sh[j];
            o8[64 * j] = (unsigned long long)pk2(y.x, y.y) | ((unsigned long long)pk2(y.z, y.w) << 32); }
#pragma unroll
        for (int j = 0; j < 8; ++j) v[j] = nv[j];
    }
}
__device__ __forceinline__ void final_norm_phase(Frame& F, const float* x, float* out, const float* gfin) {
    const int gw = F.vcu * NWAVES + F.wave, NGW = F.G * NWAVES;
    f32x4 gs[8];
#pragma unroll
    for (int j = 0; j < 8; ++j) gs[j] = *(const GAS f32x4*)(gfin + 4 * F.lane + 256 * j);
    for (int r = gw; r < M; r += NGW) {
        const GAS f32x4* xr = (const GAS f32x4*)(x + (size_t)r * D) + F.lane;
        f32x4 v[8]; float s = 0.f;
#pragma unroll
        for (int j = 0; j < 8; ++j) { v[j] = xr[64 * j]; s += (v[j].x * v[j].x + v[j].y * v[j].y) + (v[j].z * v[j].z + v[j].w * v[j].w); }
        const float rstd = 1.0f / sqrtf(wave_sum(s) * (1.0f / D) + RMS_EPS);
        GAS f32x4* o = (GAS f32x4*)(out + (size_t)r * D) + F.lane;
#pragma unroll
        for (int j = 0; j < 8; ++j) { f32x4 y = v[j] * rstd * gs[j];
#ifdef DIAG_SANITIZE
            y.x = (y.x == y.x && fabsf(y.x) < 1e30f) ? y.x : 0.f; y.y = (y.y == y.y && fabsf(y.y) < 1e30f) ? y.y : 0.f; y.z = (y.z == y.z && fabsf(y.z) < 1e30f) ? y.z : 0.f; y.w = (y.w == y.w && fabsf(y.w) < 1e30f) ? y.w : 0.f;
#endif
            o[64 * j] = y; }
    }
}

struct EpiWin {
    static constexpr bool PERM = true; static constexpr bool HAS_MID = false;
    unsigned char* ws;
    __device__ __forceinline__ void operator()(const pg8::f32x4 (&acc)[2][2][4][2], const pg8::Unit& u, int wr, int wc, int fr, int fq) const {
        const int b = u.pm >> 4, s0 = (u.pm & 15) * 256 + wr * 64 + fr, pn = u.pn;
        const size_t row0 = (size_t)b * SEQ + s0;
#pragma unroll
        for (int bj = 0; bj < 2; ++bj) {
            const int c0 = pn * 256 + bj * 128 + wc * 32 + 8 * fq;
            int mode = 0; bf16* d16 = nullptr; float* d32 = nullptr; size_t rs = 0; float sc = 1.f;
            if (pn < 4) { d16 = (bf16*)(ws + WS_QN) + ((size_t)(b * 16 + (c0 >> 6)) * SEQ + s0) * 64 + (c0 & 63); rs = 64; sc = QSCALE; }
            else if (pn < 10) { const int c = c0 - 1024; d16 = (bf16*)(ws + WS_KV) + ((size_t)(((c >> 8) * NB + b) * 4 + ((c >> 6) & 3)) * SEQ + s0) * 64 + (c & 63); rs = 64; }
            else if (pn < 14) { d16 = (bf16*)(ws + WS_QD) + row0 * 1024 + (c0 - 2560); rs = 1024; }
            else if (pn == 14) { d32 = (float*)(ws + WS_CKVR) + row0 * 256 + (c0 - 3584); rs = 256; mode = 2; }
            else if (pn < 17) { d16 = (bf16*)(ws + WS_QI) + row0 * 512 + (c0 - 3840); rs = 512; }
            else if (pn == 17) { const int c = c0 - 4352;
                if (c < 32) { d16 = (bf16*)(ws + WS_KI) + row0 * 32 + c; rs = 32; }
                else if (c < 48) { d32 = (float*)(ws + WS_WI) + row0 * 16 + (c - 32); rs = 16; mode = 2; sc = INDEX_SCALE; }
                else if (c < 96) { d32 = (float*)(ws + WS_GN) + row0 * 48 + (c - 48); rs = 48; mode = 3; }
                else mode = 5; }
            else { d16 = (bf16*)(ws + WS_AM) + row0 * 4096 + (c0 - 4608); rs = 4096; mode = 1; }
            if (mode == 5) continue;
#pragma unroll
            for (int ai = 0; ai < 2; ++ai)
#pragma unroll
                for (int m = 0; m < 4; ++m) {
                    pg8::f32x4 v0 = acc[ai][bj][m][0], v1 = acc[ai][bj][m][1];
                    if (mode & 1) { v0 = (pg8::f32x4){sigmoid_f(v0[0]), sigmoid_f(v0[1]), sigmoid_f(v0[2]), sigmoid_f(v0[3])}; v1 = (pg8::f32x4){sigmoid_f(v1[0]), sigmoid_f(v1[1]), sigmoid_f(v1[2]), sigmoid_f(v1[3])}; }
                    else { v0 = v0 * sc; v1 = v1 * sc; }
                    const size_t ro = (size_t)(ai * 128 + m * 16) * rs;
                    if (mode < 2) { pg8::u32x4 w; w.x = pg8::cvt_pk_bf16(v0[0], v0[1]); w.y = pg8::cvt_pk_bf16(v0[2], v0[3]); w.z = pg8::cvt_pk_bf16(v1[0], v1[1]); w.w = pg8::cvt_pk_bf16(v1[2], v1[3]);
                        *(pg8::u32x4*)(d16 + ro) = w; }
                    else { *(pg8::f32x4*)(d32 + ro) = v0; *(pg8::f32x4*)(d32 + ro + 4) = v1; }
                    asm volatile("" ::: "memory");
                }
        }
    }
};
struct EpiCmp1 {
    static constexpr bool PERM = true; static constexpr bool HAS_MID = false;
    bf16* O; const float* b1;
    __device__ __forceinline__ void operator()(const pg8::f32x4 (&acc)[2][2][4][2], const pg8::Unit& u, int wr, int wc, int fr, int fq) const {
        const int row0 = u.pm * 256 + wr * 64 + fr;
#pragma unroll
        for (int bj = 0; bj < 2; ++bj) {
            const int col0 = bj * 128 + wc * 32 + 8 * fq;
            const pg8::f32x4 bA = *(const pg8::f32x4*)(b1 + u.pn * 256 + col0), bB = *(const pg8::f32x4*)(b1 + u.pn * 256 + col0 + 4);
#pragma unroll
            for (int ai = 0; ai < 2; ++ai)
#pragma unroll
                for (int m = 0; m < 4; ++m) {
                    const pg8::f32x4 v0 = acc[ai][bj][m][0] + bA, v1 = acc[ai][bj][m][1] + bB;
                    pg8::u32x4 w; w.x = pg8::cvt_pk_bf16(silu_f(v0[0]), silu_f(v0[1])); w.y = pg8::cvt_pk_bf16(silu_f(v0[2]), silu_f(v0[3]));
                    w.z = pg8::cvt_pk_bf16(silu_f(v1[0]), silu_f(v1[1])); w.w = pg8::cvt_pk_bf16(silu_f(v1[2]), silu_f(v1[3]));
                    *(pg8::u32x4*)(O + (size_t)(row0 + ai * 128 + m * 16) * 256 + col0) = w;
                    asm volatile("" ::: "memory");
                }
        }
    }
};
struct CmpOrder {
    int G, c;
    __device__ __forceinline__ bool next(int i, pg8::Unit& u) const { const int L = i * G + c; if (L >= 32) return false; u.pm = L; u.pn = L >> 4; return true; }
    __device__ __forceinline__ void a_ready(const pg8::Unit&) const {}
    __device__ __forceinline__ void done(const pg8::Unit&) const {}
};
struct EpiUpF {
    static constexpr bool PERM = false; static constexpr bool HAS_MID = true;
    const bf16* AM; bf16* Y;
    static __device__ __forceinline__ pg8::f32x4 up4(pg8::u32x2 a) { return (pg8::f32x4){__uint_as_float(a.x << 16), __uint_as_float(a.x & 0xffff0000u), __uint_as_float(a.y << 16), __uint_as_float(a.y & 0xffff0000u)}; }
    __device__ __forceinline__ void mid(pg8::f32x4 (&acc)[2][2][4][2], const pg8::Unit& u, int wr, int wc, int fr, int fq) const {
        int row0 = u.pm * 256 + wr * 64 + fr, col0 = u.pn * 256 + wc * 32 + 4 * fq;
        asm volatile("" : "+v"(row0), "+v"(col0));
#pragma unroll
        for (int ai = 0; ai < 2; ++ai)
#pragma unroll
            for (int m = 0; m < 4; ++m) { const bf16* ap = AM + (size_t)(row0 + ai * 128 + m * 16) * 4096 + col0;
#pragma unroll
                for (int bj = 0; bj < 2; ++bj)
#pragma unroll
                    for (int n = 0; n < 2; ++n) { const int c = bj * 128 + n * 16;
                        const pg8::f32x4 a0 = up4(*(const pg8::u32x2*)(ap + c)), a1 = up4(*(const pg8::u32x2*)(ap + 2048 + c));
                        pg8::f32x4 r; r[0] = a0[0] * __builtin_amdgcn_rcpf(fmaxf(a1[0], 1e-30f)); r[1] = a0[1] * __builtin_amdgcn_rcpf(fmaxf(a1[1], 1e-30f)); r[2] = a0[2] * __builtin_amdgcn_rcpf(fmaxf(a1[2], 1e-30f)); r[3] = a0[3] * __builtin_amdgcn_rcpf(fmaxf(a1[3], 1e-30f));
                        acc[ai][bj][m][n] = acc[ai][bj][m][n] * r; }
                asm volatile("" ::: "memory"); }
    }
    __device__ __forceinline__ void operator()(const pg8::f32x4 (&acc)[2][2][4][2], const pg8::Unit& u, int wr, int wc, int fr, int fq) const {
        const int row0 = u.pm * 256 + wr * 64 + fr, col0 = u.pn * 256 + wc * 32 + 4 * fq;
#pragma unroll
        for (int ai = 0; ai < 2; ++ai)
#pragma unroll
            for (int m = 0; m < 4; ++m) { const size_t r = (size_t)(row0 + ai * 128 + m * 16);
#pragma unroll
                for (int bj = 0; bj < 2; ++bj)
#pragma unroll
                    for (int n = 0; n < 2; ++n) { const int c = col0 + bj * 128 + n * 16;
                        const pg8::f32x4 y = up4(*(const pg8::u32x2*)(AM + r * 4096 + 2048 + c)) * acc[ai][bj][m][n];
                        pg8::u32x2 w; w.x = pg8::cvt_pk_bf16(y[0], y[1]); w.y = pg8::cvt_pk_bf16(y[2], y[3]);
                        *(pg8::u32x2*)(Y + r * D + c) = w; }
                asm volatile("" ::: "memory"); }
    }
};

typedef float f32x16 __attribute__((ext_vector_type(16)));
typedef short s16x4 __attribute__((ext_vector_type(4)));
typedef unsigned long long u64;
#define MFMA16(a, b, c) __builtin_amdgcn_mfma_f32_16x16x32_bf16((a), (b), (c), 0, 0, 0)
#define MFMA32(a, b, c) __builtin_amdgcn_mfma_f32_32x32x16_bf16((a), (b), (c), 0, 0, 0)

__device__ __forceinline__ void ckvnorm_rows(const float* raw, bf16* out, const float* gkv, int w0, int nw, int lane) {
    const f32x4 g = *(const GAS f32x4*)(gkv + 4 * lane);
#pragma unroll 1
    for (int r = w0; r < M; r += 4 * nw) {
        f32x4 v[4];
#pragma unroll
        for (int u = 0; u < 4; ++u) { const int rr = min(r + u * nw, M - 1); v[u] = *(const GAS f32x4*)(raw + (size_t)rr * 256 + 4 * lane); }
#pragma unroll
        for (int u = 0; u < 4; ++u) { const int rr = r + u * nw;
            const float ss = wave_sum((v[u].x * v[u].x + v[u].y * v[u].y) + (v[u].z * v[u].z + v[u].w * v[u].w));
            const float rstd = 1.0f / sqrtf(ss * (1.0f / 256.0f) + RMS_EPS);
            const f32x4 y = v[u] * rstd * g;
            if (rr < M) *(GAS unsigned long long*)(out + (size_t)rr * 256 + 4 * lane) = (unsigned long long)pk2(y.x, y.y) | ((unsigned long long)pk2(y.z, y.w) << 32); }
    }
}
__device__ __forceinline__ void qlat_items(const bf16* QD, const bf16* WUK, bf16* QLAT, int pair, int npairs, int sub, int wave, int lane) {
    const int fr = lane & 15, fq = lane >> 4, h = sub * 8 + wave;
    bf16x8 wa[16][2];
#pragma unroll
    for (int pm = 0; pm < 16; ++pm) { const int c = 64 * (pm >> 2) + 32 * ((pm >> 1) & 1) + 8 * (fr >> 2) + 4 * (pm & 1) + (fr & 3);
#pragma unroll
        for (int ks = 0; ks < 2; ++ks) wa[pm][ks] = *(const GAS bf16x8*)(WUK + (size_t)c * 1024 + h * 64 + 32 * ks + 8 * fq); }
    const bf16* qp = QD + (size_t)fr * 1024 + h * 64 + 8 * fq;
    bf16* op = QLAT + (size_t)fr * 4096 + h * 256 + 8 * fq;
    bf16x8 q0, q1, n0, n1;
    if (pair < M / 16) { q0 = *(const GAS bf16x8*)(qp + (size_t)pair * 16 * 1024); q1 = *(const GAS bf16x8*)(qp + (size_t)pair * 16 * 1024 + 32); }
#pragma unroll 1
    for (int tile = pair; tile < M / 16; tile += npairs) {
        const int nt = min(tile + npairs, M / 16 - 1);
        n0 = *(const GAS bf16x8*)(qp + (size_t)nt * 16 * 1024); n1 = *(const GAS bf16x8*)(qp + (size_t)nt * 16 * 1024 + 32);
        bf16* o = op + (size_t)tile * 16 * 4096;
#pragma unroll
        for (int ps = 0; ps < 8; ++ps) {
            f32x4 d0 = MFMA16(wa[2 * ps][0], q0, ((f32x4){0.f, 0.f, 0.f, 0.f})); d0 = MFMA16(wa[2 * ps][1], q1, d0);
            f32x4 d1 = MFMA16(wa[2 * ps + 1][0], q0, ((f32x4){0.f, 0.f, 0.f, 0.f})); d1 = MFMA16(wa[2 * ps + 1][1], q1, d1);
            pg8::u32x4 w; w.x = cvtpk(d0[0], d0[1]); w.y = cvtpk(d0[2], d0[3]); w.z = cvtpk(d1[0], d1[1]); w.w = cvtpk(d1[2], d1[3]);
            *(GAS pg8::u32x4*)(o + 32 * ps) = w;
        }
        q0 = n0; q1 = n1;
    }
}
__device__ __forceinline__ void cmp2_items(const bf16* Hd, const bf16* W2T, bf16* OUT, int it0, int it1, int w0, int nw, int lane) {
    const int fr = lane & 15, fq = lane >> 4, kv = (it0 * 16) >> 12;
    if (it0 + w0 >= it1) return;
    bf16x8 wa[4][8], hb[8];
#pragma unroll
    for (int ks = 0; ks < 8; ++ks) hb[ks] = *(const GAS bf16x8*)(Hd + (size_t)((it0 + w0) * 16 + fr) * 256 + 32 * ks + 8 * fq);
#pragma unroll
    for (int dt = 0; dt < 4; ++dt)
#pragma unroll
        for (int ks = 0; ks < 8; ++ks) wa[dt][ks] = *(const GAS bf16x8*)(W2T + (size_t)(kv * 64 + 16 * dt + fr) * 256 + 32 * ks + 8 * fq);
#pragma unroll 1
    for (int it = it0 + w0; it < it1; it += nw) {
        const int r0 = it * 16, nx = min(it + nw, it1 - 1);
        bf16x8 nb[8];
#pragma unroll
        for (int ks = 0; ks < 8; ++ks) nb[ks] = *(const GAS bf16x8*)(Hd + (size_t)(nx * 16 + fr) * 256 + 32 * ks + 8 * fq);
#pragma unroll
        for (int dt = 0; dt < 4; ++dt) {
            f32x4 d = {0.f, 0.f, 0.f, 0.f};
#pragma unroll
            for (int ks = 0; ks < 8; ++ks) d = MFMA16(wa[dt][ks], hb[ks], d);
            *(GAS unsigned long long*)(OUT + (size_t)(r0 + fr) * 64 + 16 * dt + 4 * fq) = (unsigned long long)cvtpk(d[0], d[1]) | ((unsigned long long)cvtpk(d[2], d[3]) << 32);
        }
#pragma unroll
        for (int ks = 0; ks < 8; ++ks) hb[ks] = nb[ks];
    }
}
__device__ __forceinline__ void od_items(const bf16* OLAT, const bf16* WUVT, bf16* OD, int vcu, int G, int wave, int lane) {
    const int fr = lane & 15, fq = lane >> 4, h = (vcu & 1) * 8 + wave;
    bf16x8 wa[4][8];
#pragma unroll
    for (int m = 0; m < 4; ++m) { const int d = 32 * (m >> 1) + 8 * (fr >> 2) + 4 * (m & 1) + (fr & 3);
#pragma unroll
        for (int ks = 0; ks < 8; ++ks) wa[m][ks] = *(const GAS bf16x8*)(WUVT + (size_t)(h * 64 + d) * 256 + 32 * ks + 8 * fq); }
#pragma unroll 1
  for (int tb = (vcu >> 1) * 128; tb < M; tb += (G >> 1) * 128) {
    const bf16* ip = OLAT + (size_t)(tb + fr) * 4096 + h * 256 + 8 * fq;
    bf16* op = OD + (size_t)(tb + fr) * 2048 + 1024 + h * 64 + 8 * fq;
    bf16x8 ob[8], nb[8];
#pragma unroll
    for (int ks = 0; ks < 8; ++ks) ob[ks] = *(const GAS bf16x8*)(ip + 32 * ks);
#pragma unroll 1
    for (int tile = 0; tile < 8; ++tile) {
        const bf16* np = ip + (size_t)min(tile + 1, 7) * 16 * 4096;
#pragma unroll
        for (int ks = 0; ks < 8; ++ks) nb[ks] = *(const GAS bf16x8*)(np + 32 * ks);
        f32x4 d[4];
#pragma unroll
        for (int m = 0; m < 4; ++m) { d[m] = (f32x4){0.f, 0.f, 0.f, 0.f};
#pragma unroll
            for (int ks = 0; ks < 8; ++ks) d[m] = MFMA16(wa[m][ks], ob[ks], d[m]); }
#pragma unroll
        for (int sI = 0; sI < 2; ++sI) { pg8::u32x4 w; w.x = cvtpk(d[2 * sI][0], d[2 * sI][1]); w.y = cvtpk(d[2 * sI][2], d[2 * sI][3]); w.z = cvtpk(d[2 * sI + 1][0], d[2 * sI + 1][1]); w.w = cvtpk(d[2 * sI + 1][2], d[2 * sI + 1][3]);
            *(GAS pg8::u32x4*)(op + (size_t)tile * 16 * 2048 + 32 * sI) = w; }
#pragma unroll
        for (int ks = 0; ks < 8; ++ks) ob[ks] = nb[ks];
    }
  }
}

constexpr int NS_K = 0, NS_V = 16384, NS_IMP = 32768, NS_MASK = NS_IMP + 65536;
constexpr int LUTN_OFF = EXTRA_OFF, LUTD_OFF = EXTRA_OFF + 8192, IDXL_OFF = EXTRA_OFF + 16384;
__device__ __forceinline__ int mbcnt64(u64 m) { return __builtin_amdgcn_mbcnt_hi((unsigned)(m >> 32), __builtin_amdgcn_mbcnt_lo((unsigned)m, 0u)); }
__device__ __forceinline__ int crow(int r, int hi) { return (r & 3) + 8 * (r >> 2) + 4 * hi; }
__device__ __forceinline__ int t5_bucket(int n) { return n < 16 ? n : min(31, 16 + (int)(logf((float)n * (1.0f / 16.0f)) / 2.0794415416798357f * 16.0f)); }
__device__ __forceinline__ void build_luts(Frame& F, const float* relb) {
    LAS float* ln = (LAS float*)(F.lds + LUTN_OFF); LAS float* ld = (LAS float*)(F.lds + LUTD_OFF);
    for (int i = F.tid; i < 16 * 128; i += NWAVES * 64) { const int h = i >> 7, bk = t5_bucket(i & 127); ln[i] = relb[bk * 32 + h] * LOG2E; ld[i] = relb[bk * 32 + 16 + h] * LOG2E; }
    __syncthreads();
}
struct NsaSm { float m, l; };
__device__ __forceinline__ void nsa_scores(f32x16& p0, f32x16& p1, LAS const unsigned char* Kt, const bf16x8 (&qr)[4], float cin, int r32, int hi) {
#pragma unroll
    for (int r = 0; r < 16; ++r) { p0[r] = cin; p1[r] = cin; }
    const int sw = (r32 >> 1) & 7;
    LAS const unsigned char* k0 = Kt + r32 * 128; LAS const unsigned char* k1 = k0 + 32 * 128;
#pragma unroll
    for (int d0 = 0; d0 < 4; ++d0) {
        const int ch = ((2 * d0 + hi) ^ sw) << 4;
        const bf16x8 a0 = *(LAS const bf16x8*)(k0 + ch), a1 = *(LAS const bf16x8*)(k1 + ch);
        p0 = MFMA32(a0, qr[d0], p0); p1 = MFMA32(a1, qr[d0], p1);
    }
}
__device__ __forceinline__ void nsa_near(f32x16& p0, f32x16& p1, int dbase, int stride, int lim, LAS const float* lut, int hi) {
    int db = dbase - stride * 4 * hi; asm volatile("" : "+v"(db));
#pragma unroll
    for (int r = 0; r < 16; ++r) {
        const int d0 = db - stride * ((r & 3) + 8 * (r >> 2)), d1 = d0 - stride * 32;
        const float b0 = lut[min(max(d0, 0), 127)], b1 = lut[min(max(d1, 0), 127)];
        p0[r] = (d0 >= 0 && d0 < lim) ? p0[r] + b0 : -INFINITY; p1[r] = (d1 >= 0 && d1 < lim) ? p1[r] + b1 : -INFINITY;
    }
}
__device__ __forceinline__ float nsa_rowmax(const f32x16& p0, const f32x16& p1) {
    float a = __builtin_elementwise_maximum(p0[0], p1[0]);
#pragma unroll
    for (int r = 1; r < 16; ++r) a = __builtin_elementwise_maximum(a, __builtin_elementwise_maximum(p0[r], p1[r]));
    return xmax32(a);
}
__device__ __forceinline__ void nsa_pv(f32x16& o0, f32x16& o1, LAS const unsigned char* Vt, const bf16x8 (&pk)[4], int lane) {
    const int hi = lane >> 5, G = (lane >> 4) & 1, q_ = (lane & 15) >> 2, p_ = lane & 3;
    const int sw = ((q_ >> 1) & 1) << 2;
    const int rowoff = (4 * hi + q_) * 128 + (p_ & 1) * 8;
    const int c0 = (((2 * G + (p_ >> 1)) ^ sw) << 4), c1 = (((4 + 2 * G + (p_ >> 1)) ^ sw) << 4);
#pragma unroll
    for (int sb = 0; sb < 2; ++sb) {
        s16x4 al[2][2], ah[2][2];
#pragma unroll
        for (int s2 = 0; s2 < 2; ++s2) { LAS const unsigned char* base = Vt + (2 * sb + s2) * 16 * 128 + rowoff;
            al[s2][0] = __builtin_bit_cast(s16x4, __builtin_amdgcn_ds_read_tr16_b64_v4i16((LAS s16x4*)(base + c0)));
            ah[s2][0] = __builtin_bit_cast(s16x4, __builtin_amdgcn_ds_read_tr16_b64_v4i16((LAS s16x4*)(base + c0 + 8 * 128)));
            al[s2][1] = __builtin_bit_cast(s16x4, __builtin_amdgcn_ds_read_tr16_b64_v4i16((LAS s16x4*)(base + c1)));
            ah[s2][1] = __builtin_bit_cast(s16x4, __builtin_amdgcn_ds_read_tr16_b64_v4i16((LAS s16x4*)(base + c1 + 8 * 128))); }
#pragma unroll
        for (int s2 = 0; s2 < 2; ++s2) {
            const bf16x8 v0 = {al[s2][0][0], al[s2][0][1], al[s2][0][2], al[s2][0][3], ah[s2][0][0], ah[s2][0][1], ah[s2][0][2], ah[s2][0][3]};
            const bf16x8 v1 = {al[s2][1][0], al[s2][1][1], al[s2][1][2], al[s2][1][3], ah[s2][1][0], ah[s2][1][1], ah[s2][1][2], ah[s2][1][3]};
            o0 = MFMA32(v0, pk[2 * sb + s2], o0); o1 = MFMA32(v1, pk[2 * sb + s2], o1); }
    }
}
__device__ __forceinline__ void nsa_pack(bf16x8 (&pk)[4], const f32x16& p0, const f32x16& p1) {
#pragma unroll
    for (int s = 0; s < 2; ++s) {
        pg8::u32x4 w0, w1;
        w0.x = cvtpk(p0[8 * s + 0], p0[8 * s + 1]); w0.y = cvtpk(p0[8 * s + 2], p0[8 * s + 3]); w0.z = cvtpk(p0[8 * s + 4], p0[8 * s + 5]); w0.w = cvtpk(p0[8 * s + 6], p0[8 * s + 7]);
        w1.x = cvtpk(p1[8 * s + 0], p1[8 * s + 1]); w1.y = cvtpk(p1[8 * s + 2], p1[8 * s + 3]); w1.z = cvtpk(p1[8 * s + 4], p1[8 * s + 5]); w1.w = cvtpk(p1[8 * s + 6], p1[8 * s + 7]);
        pk[s] = __builtin_bit_cast(bf16x8, w0); pk[2 + s] = __builtin_bit_cast(bf16x8, w1);
    }
}
__device__ __forceinline__ void nsa_online(f32x16& p0, f32x16& p1, NsaSm& st, f32x16& o0, f32x16& o1, LAS const unsigned char* Vt, int lane, float cin) {
    const float mx = nsa_rowmax(p0, p1) + cin, mn = fmaxf(st.m, mx), alpha = __builtin_amdgcn_exp2f(st.m - mn), off = mn - cin;
    st.m = mn; float sum = 0.f;
#pragma unroll
    for (int r = 0; r < 16; ++r) { p0[r] = __builtin_amdgcn_exp2f(p0[r] - off); p1[r] = __builtin_amdgcn_exp2f(p1[r] - off); sum += p0[r] + p1[r]; }
    st.l = st.l * alpha + sum;
    if (__any(alpha != 1.0f)) {
#pragma unroll
        for (int r = 0; r < 16; ++r) { o0[r] *= alpha; o1[r] *= alpha; } }
    bf16x8 pk[4]; nsa_pack(pk, p0, p1);
    nsa_pv(o0, o1, Vt, pk, lane);
}
__device__ __forceinline__ void nsa_stage_store(LAS unsigned char* lds, int buf, int tid, const v4u& kr, const v4u& vr) {
    const int key = tid >> 3, ch = tid & 7;
    *(LAS v4u*)(lds + NS_K + buf * 8192 + key * 128 + ((ch ^ ((key >> 1) & 7)) << 4)) = kr;
    *(LAS v4u*)(lds + NS_V + buf * 8192 + key * 128 + ((ch ^ (((key >> 1) & 1) << 2)) << 4)) = vr;
}

__device__ __forceinline__ void nsa_unit(Frame& F, int b, int g, int i, const bf16* QN, const bf16* KV, const bf16* KCMP, const float* GN, bf16* ON, int& itc) {
    const int tid = F.tid, lane = F.lane, r32 = lane & 31, hi = lane >> 5, hh = F.wave & 3, th = F.wave >> 2, h = 4 * g + hh;
    const int t0 = 64 * i, tw0 = t0 + 32 * th, t = tw0 + r32;
    LAS unsigned char* lds = F.lds + RING_OFF;
    LAS const float* lut = (LAS const float*)(F.lds + LUTN_OFF) + h * 128;
    const float b31 = lut[127];
    bf16x8 qr[4];
#pragma unroll
    for (int d0 = 0; d0 < 4; ++d0) qr[d0] = *(const GAS bf16x8*)(QN + ((size_t)(b * 16 + h) * SEQ + t) * 64 + 16 * d0 + 8 * hi);
    const float* gp = GN + (size_t)(b * SEQ + t) * 48 + h * 3;
    const float g0 = gp[0], g1 = gp[1], g2 = gp[2];
    const int bg = b * 4 + g;
    const bf16 *Kc, *Vc, *Ks, *Vs, *Kw, *Vw;
    f32x16 oc0, oc1;
    LAS float* accl = (LAS float*)(lds + NS_IMP) + F.wave * 2048 + lane;
    v4u kr, vr; const unsigned toff = (unsigned)tid * 16u;
#define NSA_LOAD(Kp, Vp, jb) do { kr = *(const GAS v4u*)((const GAS char*)((Kp) + (size_t)(jb) * 4096) + toff); vr = *(const GAS v4u*)((const GAS char*)((Vp) + (size_t)(jb) * 4096) + toff); } while (0)
#define NSA_STAGE() do { nsa_stage_store(lds, itc & 1, tid, kr, vr); } while (0)
#define NSA_BAR() asm volatile("s_waitcnt lgkmcnt(0)\n\ts_barrier" ::: "memory")
#define NSA_KT (lds + NS_K + (itc & 1) * 8192)
#define NSA_VT (lds + NS_V + (itc & 1) * 8192)
    const int ncb = ((min((t0 + 32) >> 4, 254)) >> 6) + 1;
    NsaSm sc{-1e30f, 0.f};
    Kc = launder(KCMP) + (size_t)bg * 256 * 64; Vc = Kc + (size_t)16 * 256 * 64;
    NSA_LOAD(Kc, Vc, 0);
    for (int jb = 0; jb < ncb; ++jb) {
        NSA_STAGE(); if (jb + 1 < ncb) NSA_LOAD(Kc, Vc, jb + 1); else NSA_LOAD(Kc, Vc, 0);
        NSA_BAR();
        f32x16 p0, p1;
        const int dmin = tw0 - 31 - 16 * (64 * jb + 63);
        nsa_scores(p0, p1, NSA_KT, qr, 0.f, r32, hi);
        float cin = b31;
        if (dmin < 113) { nsa_near(p0, p1, t - 31 - 1024 * jb, 16, 1 << 30, lut, hi); cin = 0.f; }
        const float mx = nsa_rowmax(p0, p1) + cin, mn = fmaxf(sc.m, mx), alpha = __builtin_amdgcn_exp2f(sc.m - mn), off = mn - cin;
        sc.m = mn; float sum = 0.f;
#pragma unroll
        for (int r = 0; r < 16; ++r) sum += __builtin_amdgcn_exp2f(p0[r] - off) + __builtin_amdgcn_exp2f(p1[r] - off);
        sc.l = sc.l * alpha + sum;
        ++itc;
    }
    {
        const float lt = xsum32(sc.l), inv = lt > 0.f ? 1.0f / lt : 0.f;
        f32x16 o0, o1;
#pragma unroll
        for (int r = 0; r < 16; ++r) { o0[r] = 0.f; o1[r] = 0.f; }
        float carry = 0.f;
        LAS float* imp = (LAS float*)(lds + NS_IMP) + (hh * 64 + 32 * th + r32) * 64;
#pragma unroll 1
        for (int jb = 0; jb < 4; ++jb) {
            float X[8];
#pragma unroll
            for (int a = 0; a < 8; ++a) X[a] = 0.f;
            if (jb < ncb) {
                NSA_STAGE(); if (jb + 1 < ncb) NSA_LOAD(Kc, Vc, jb + 1);
                NSA_BAR();
                f32x16 p0, p1;
                const int dmin = tw0 - 31 - 16 * (64 * jb + 63);
                nsa_scores(p0, p1, NSA_KT, qr, 0.f, r32, hi);
                float off = sc.m - b31;
                if (dmin < 113) { nsa_near(p0, p1, t - 31 - 1024 * jb, 16, 1 << 30, lut, hi); off = sc.m; }
#pragma unroll
                for (int r = 0; r < 16; ++r) { p0[r] = __builtin_amdgcn_exp2f(p0[r] - off) * inv; p1[r] = __builtin_amdgcn_exp2f(p1[r] - off) * inv; }
                X[0] = hi ? 0.f : carry;
#pragma unroll
                for (int a = 0; a < 8; ++a) {
                    const int ra = 4 * (a & 3);
                    const float e0 = a < 4 ? p0[ra] : p1[ra], e1 = a < 4 ? p0[ra + 1] : p1[ra + 1], e2 = a < 4 ? p0[ra + 2] : p1[ra + 2], e3 = a < 4 ? p0[ra + 3] : p1[ra + 3];
                    const float other = xget32(e3, hi != 0);
                    X[a] += (e0 + e1) + (e2 + e3);
                    if (hi) X[a] += other; else { if (a < 7) X[a + 1] += other; else carry = other; }
                }
                bf16x8 pk[4]; nsa_pack(pk, p0, p1);
                nsa_pv(o0, o1, NSA_VT, pk, lane);
                ++itc;
            }
#pragma unroll
            for (int a = 0; a < 8; ++a) imp[16 * jb + 2 * a + hi] = X[a];
        }
#pragma unroll
        for (int r = 0; r < 16; ++r) { oc0[r] = g0 * o0[r]; oc1[r] = g0 * o1[r]; }
    }
    __syncthreads();
    {
        LAS const float* impb = (LAS const float*)(lds + NS_IMP);
        LAS u64* maskl = (LAS u64*)(lds + NS_MASK);
#pragma unroll 1
        for (int q = 0; q < 8; ++q) {
            const int tok = F.wave * 8 + q, j = lane;
            const float v = ((impb[(0 * 64 + tok) * 64 + j] + impb[(1 * 64 + tok) * 64 + j]) + impb[(2 * 64 + tok) * 64 + j]) + impb[(3 * 64 + tok) * 64 + j];
            const bool vis = j <= i, forced = vis && ((j == 0) | (j == i) | (j == i - 1)), cand = vis && !forced;
            const int k = 16 - __builtin_popcountll(__ballot(forced)), ncand = __builtin_popcountll(__ballot(cand));
            const float vc = cand ? v : -INFINITY;
            u64 msk;
            if (ncand <= k) msk = __ballot(vis);
            else {
                float lo = 0.f, hi = 8.f, thr = 0.f;
                for (int itn = 0; itn < 64; ++itn) {
                    const float mid = 0.5f * (lo + hi);
                    if (!(mid > lo && mid < hi)) { thr = lo; break; }
                    const int c = __builtin_popcountll(__ballot(vc >= mid));
                    if (c == k) { thr = mid; break; }
                    if (c > k) lo = mid; else hi = mid;
                    thr = lo;
                }
                const int need = k - __builtin_popcountll(__ballot(vc > thr));
                const bool eq = vc == thr; const u64 meq = __ballot(eq);
                msk = __ballot(forced || (vc > thr) || (eq && mbcnt64(meq) < need));
            }
            if (lane == 0) maskl[tok] = msk;
        }
    }
    __syncthreads();
    const u64 mymask = ((LAS const u64*)(lds + NS_MASK))[32 * th + r32];
#pragma unroll
    for (int r = 0; r < 16; ++r) { accl[r * 64] = oc0[r]; accl[(16 + r) * 64] = oc1[r]; }
    {
        NsaSm ss{-1e30f, 0.f}; f32x16 o0, o1;
#pragma unroll
        for (int r = 0; r < 16; ++r) { o0[r] = 0.f; o1[r] = 0.f; }
        Ks = launder(KV) + ((size_t)(2 * NB * 4 + bg) * SEQ) * 64; Vs = Ks + ((size_t)NB * 4 * SEQ) * 64;
        NSA_LOAD(Ks, Vs, 0);
#ifndef NSA_SKIP_SEL
        for (int jb = 0; jb <= i; ++jb) {
            NSA_STAGE(); if (jb < i) NSA_LOAD(Ks, Vs, jb + 1);
            NSA_BAR();
            const bool att = (mymask >> jb) & 1ull;
            f32x16 p0, p1;
            const int dmin = tw0 - 64 * jb - 63;
            nsa_scores(p0, p1, NSA_KT, qr, 0.f, r32, hi);
            float cin = att ? b31 : -INFINITY;
            if (dmin < 113) { nsa_near(p0, p1, t - 64 * jb, 1, 1 << 30, lut, hi); cin = att ? 0.f : -INFINITY; }
            nsa_online(p0, p1, ss, o0, o1, NSA_VT, lane, cin);
            ++itc;
        }
#endif
        const float lt = xsum32(ss.l), f = lt > 0.f ? g1 / lt : 0.f;
#pragma unroll
        for (int r = 0; r < 16; ++r) { accl[r * 64] += f * o0[r]; accl[(16 + r) * 64] += f * o1[r]; }
    }
    {
        NsaSm sw{-1e30f, 0.f}; f32x16 o0, o1;
#pragma unroll
        for (int r = 0; r < 16; ++r) { o0[r] = 0.f; o1[r] = 0.f; }
#ifdef WIN_AS_CAUSAL
        const int j0 = 0;
#else
        const int j0 = max(i - 8, 0);
#endif
        Kw = launder(KV) + ((size_t)(4 * NB * 4 + bg) * SEQ) * 64; Vw = Kw + ((size_t)NB * 4 * SEQ) * 64;
        NSA_LOAD(Kw, Vw, j0);
#ifndef NSA_SKIP_WIN
        for (int jb = j0; jb <= i; ++jb) {
            NSA_STAGE(); if (jb < i) NSA_LOAD(Kw, Vw, jb + 1);
            NSA_BAR();
            f32x16 p0, p1;
            const int dmin = tw0 - 64 * jb - 63, dmax = tw0 + 31 - 64 * jb;
#ifdef WIN_AS_CAUSAL
            nsa_scores(p0, p1, NSA_KT, qr, 0.f, r32, hi);
            float cin = b31;
            if (dmin < 113) { nsa_near(p0, p1, t - 64 * jb, 1, 1 << 30, lut, hi); cin = 0.f; }
#else
            nsa_scores(p0, p1, NSA_KT, qr, 0.f, r32, hi);
            float cin = b31;
            if (!(dmin >= 113 && dmax < 512)) { nsa_near(p0, p1, t - 64 * jb, 1, 512, lut, hi); cin = 0.f; }
#endif
            nsa_online(p0, p1, sw, o0, o1, NSA_VT, lane, cin);
            ++itc;
        }
#endif
        const float lt = xsum32(sw.l), f = lt > 0.f ? g2 / lt : 0.f;
#pragma unroll
        for (int r = 0; r < 16; ++r) { o0[r] = accl[r * 64] + f * o0[r]; o1[r] = accl[(16 + r) * 64] + f * o1[r]; }
        bf16* op = ON + (size_t)(b * SEQ + t) * 2048 + h * 64 + 4 * hi;
#pragma unroll
        for (int a = 0; a < 4; ++a) {
            *(GAS unsigned long long*)(op + 8 * a) = (unsigned long long)pk2(o0[4 * a], o0[4 * a + 1]) | ((unsigned long long)pk2(o0[4 * a + 2], o0[4 * a + 3]) << 32);
            *(GAS unsigned long long*)(op + 32 + 8 * a) = (unsigned long long)pk2(o1[4 * a], o1[4 * a + 1]) | ((unsigned long long)pk2(o1[4 * a + 2], o1[4 * a + 3]) << 32);
        }
    }
#undef NSA_LOAD
#undef NSA_STAGE
#undef NSA_BAR
#undef NSA_KT
#undef NSA_VT
}

__device__ __forceinline__ unsigned f2sortable(float f) { const unsigned u = __builtin_bit_cast(unsigned, f); return u ^ ((u >> 31) ? 0xffffffffu : 0x80000000u); }

__device__ __forceinline__ void dsa_token(Frame& F, int b, int t, const bf16* QI, const bf16* KI, const float* WI, const bf16* CKVN, const bf16* QLAT, bf16* OLAT) {
    const int lane = F.lane, fr = lane & 15, fq = lane >> 4;
    const size_t row = (size_t)b * SEQ + t;
    LAS unsigned short* idxl = (LAS unsigned short*)(F.lds + IDXL_OFF + F.wave * 1024);
    LAS unsigned char* Cb = F.lds + RING_OFF + F.wave * 16384;
    LAS const float* lut = (LAS const float*)(F.lds + LUTD_OFF) + fr * 128;
    const int cmax = t >> 6;
    int nsel;
#ifndef REP_DSA_IDX
#define REP_DSA_IDX 1
#endif
#ifndef REP_DSA_ATT
#define REP_DSA_ATT 1
#endif
    for (int rep_i = 0; rep_i < REP_DSA_IDX; ++rep_i)
    {
        float sc[64];
        const bf16x8 qa = *(const GAS bf16x8*)(QI + row * 512 + fr * 32 + 8 * fq);
        const f32x4 w4 = *(const GAS f32x4*)(WI + row * 16 + 4 * fq);
        const GAS bf16* kp = (const GAS bf16*)(KI + ((size_t)b * SEQ + fr) * 32 + 8 * fq);
        bf16x8 kbuf[3][4];
        float vmax = -INFINITY, vmin = INFINITY;
#define DSA_KLOAD(c, ahead) do { _Pragma("unroll") for (int tau = 0; tau < 4; ++tau) kbuf[(c) % 3][tau] = *(const GAS bf16x8*)(kp + ((ahead) * 64 + 16 * tau) * 32); } while (0)
        const int cmax4 = cmax | 3;
        DSA_KLOAD(0, 0); DSA_KLOAD(1, 1);
#pragma unroll
        for (int c = 0; c < 64; ++c) sc[c] = -INFINITY;
#pragma unroll
        for (int g4 = 0; g4 < 16; ++g4) {
            if (4 * g4 <= cmax) {
#pragma unroll
                for (int c = 4 * g4; c < 4 * g4 + 4; ++c) {
                    asm volatile("" : "+v"(kp));
                    if (c + 2 < 64) { if (c + 2 <= cmax4) DSA_KLOAD(c + 2, 2); }
                    float v[4];
#pragma unroll
                    for (int tau = 0; tau < 4; ++tau) {
                        const f32x4 d = MFMA16(qa, kbuf[c % 3][tau], ((f32x4){0.f, 0.f, 0.f, 0.f}));
                        typedef int i32x4_ __attribute__((ext_vector_type(4)));
                        const f32x4 rl = __builtin_bit_cast(f32x4, __builtin_elementwise_max(__builtin_bit_cast(i32x4_, d), ((i32x4_){0, 0, 0, 0})));
                        v[tau] = fmaf(w4.w, rl[3], fmaf(w4.z, rl[2], fmaf(w4.y, rl[1], w4.x * rl[0])));
                    }
                    const SwapPair r0 = swap32p(v[0], v[2]), r1 = swap32p(v[1], v[3]);
                    const float a0 = __builtin_bit_cast(float, r0.a) + __builtin_bit_cast(float, r0.b), a1 = __builtin_bit_cast(float, r1.a) + __builtin_bit_cast(float, r1.b);
                    const SwapPair r2 = swap16p(a0, a1);
                    const float keep = __builtin_bit_cast(float, r2.a) + __builtin_bit_cast(float, r2.b);
                    const bool cand = 64 * c + lane <= t;
                    sc[c] = cand ? keep : -INFINITY; vmax = fmaxf(vmax, sc[c]); vmin = fminf(vmin, cand ? keep : INFINITY);
                    kp += 64 * 32;
                }
            }
        }
#undef DSA_KLOAD
        if (t < 256) {
            nsel = t + 1;
#pragma unroll
            for (int c = 0; c < 4; ++c) idxl[64 * c + lane] = (64 * c + lane <= t) ? (unsigned short)(64 * c + lane) : (unsigned short)0;
        } else {
            nsel = 256;
#define DSA_COUNT_L(OP, X, out) do { int cnt_ = 0; \
            _Pragma("unroll") for (int c = 0; c < 16; ++c) cnt_ += (sc[c] OP (X)) ? 1 : 0; \
            if (cmax >= 16) { _Pragma("unroll") for (int c = 16; c < 32; ++c) cnt_ += (sc[c] OP (X)) ? 1 : 0; } \
            if (cmax >= 32) { _Pragma("unroll") for (int c = 32; c < 48; ++c) cnt_ += (sc[c] OP (X)) ? 1 : 0; } \
            if (cmax >= 48) { _Pragma("unroll") for (int c = 48; c < 64; ++c) cnt_ += (sc[c] OP (X)) ? 1 : 0; } \
            out = cnt_; } while (0)
#define DSA_COUNT(OP, X, out) do { int l_; DSA_COUNT_L(OP, X, l_); out = wave_total_i(l_); } while (0)
            float lo = vmin, hi = vmax;
            lo = fminf(lo, swz<1>(lo)); lo = fminf(lo, swz<2>(lo)); lo = fminf(lo, swz<4>(lo)); lo = fminf(lo, swz<8>(lo)); lo = fminf(lo, swz<16>(lo)); { const SwapPair r = swap32(lo); lo = fminf(__builtin_bit_cast(float, r.a), __builtin_bit_cast(float, r.b)); }
            hi = fmaxf(hi, swz<1>(hi)); hi = fmaxf(hi, swz<2>(hi)); hi = fmaxf(hi, swz<4>(hi)); hi = fmaxf(hi, swz<8>(hi)); hi = fmaxf(hi, swz<16>(hi)); hi = xmax32(hi);
            float thr = lo; int c0; DSA_COUNT(>=, hi, c0);
            if (c0 >= 256) thr = hi;
            else {
                for (int itn = 0; itn < 64; ++itn) {
                    const float mid = lo + 0.5f * (hi - lo);
                    if (!(mid > lo && mid < hi)) { thr = lo; break; }
                    int cnt; DSA_COUNT(>=, mid, cnt);
                    if (cnt == 256) { thr = mid; break; }
                    if (cnt > 256) lo = mid; else hi = mid;
                    thr = lo;
                }
            }
            int nl; DSA_COUNT_L(>, thr, nl);
            const int cgt = wave_total_i(nl);
            const int need = 256 - cgt;
            if (need == 0) {
                int inc = nl;
                inc += __builtin_amdgcn_update_dpp(0, inc, 0x111, 0xf, 0xf, true);
                inc += __builtin_amdgcn_update_dpp(0, inc, 0x112, 0xf, 0xf, true);
                inc += __builtin_amdgcn_update_dpp(0, inc, 0x114, 0xf, 0xf, true);
                inc += __builtin_amdgcn_update_dpp(0, inc, 0x118, 0xf, 0xf, true);
                const int r0 = __builtin_amdgcn_readlane(inc, 15), r1 = r0 + __builtin_amdgcn_readlane(inc, 31), r2 = r1 + __builtin_amdgcn_readlane(inc, 47);
                int off = inc - nl + (fq == 0 ? 0 : fq == 1 ? r0 : fq == 2 ? r1 : r2);
                int key = lane; asm volatile("" : "+v"(key));
                const int dump = key + 256;
#pragma unroll
                for (int g4 = 0; g4 < 16; ++g4) {
                    if (4 * g4 <= cmax) {
#pragma unroll
                        for (int c = 4 * g4; c < 4 * g4 + 4; ++c) { const bool sel = sc[c] > thr;
                            idxl[sel ? off : dump] = (unsigned short)key; off += sel ? 1 : 0; key += 64; asm volatile("" : "+v"(key)); }
                    }
                }
            } else {
            int base = 0, eqb = 0;
#pragma unroll
            for (int g4 = 0; g4 < 16; ++g4) {
                if (4 * g4 <= cmax) {
#pragma unroll
                    for (int c = 4 * g4; c < 4 * g4 + 4; ++c) {
                        const bool eq = sc[c] == thr; const u64 meq = __ballot(eq);
                        const bool sel = (sc[c] > thr) || (eq && (eqb + mbcnt64(meq) < need));
                        const u64 ms = __ballot(sel);
                        if (sel) idxl[base + mbcnt64(ms)] = (unsigned short)(64 * c + lane);
                        base += __builtin_popcountll(ms); eqb += __builtin_popcountll(meq);
                    }
                }
            }
            }
#undef DSA_COUNT_L
#undef DSA_COUNT
        }
    }
    for (int rep_a = 0; rep_a < REP_DSA_ATT; ++rep_a) {
    bf16x8 qf[8];
    { const bf16* qp = QLAT + row * 4096 + fr * 256 + 8 * fq;
#pragma unroll
      for (int ks = 0; ks < 8; ++ks) qf[ks] = *(const GAS bf16x8*)(qp + 32 * ks); }
    f32x4 o[16];
#pragma unroll
    for (int ct = 0; ct < 16; ++ct) o[ct] = (f32x4){0.f, 0.f, 0.f, 0.f};
    float m = -1e30f, l = 0.f;
    const int nhc = (nsel + 15) >> 4;
    const GAS char* Cbase = (const GAS char*)(CKVN + (size_t)b * SEQ * 256) + fq * 16;
    bf16x8 crA[8], crB[8];
#define DSA_LOADT(cr, hc) do { const GAS char* src_ = Cbase + (size_t)idxl[16 * (hc) + fr] * 512; \
        _Pragma("unroll") for (int ks = 0; ks < 8; ++ks) cr[ks] = *(const GAS bf16x8*)(src_ + ks * 64); } while (0)
#define DSA_TILE(cr, hc) do { \
        const s16x4 ia = *(LAS const s16x4*)(idxl + 16 * (hc) + 4 * fq); \
        f32x4 s0 = {0.f, 0.f, 0.f, 0.f}; \
        _Pragma("unroll") for (int ks = 0; ks < 8; ++ks) s0 = MFMA16(cr[ks], qf[ks], s0); \
        _Pragma("unroll") for (int ks = 0; ks < 8; ++ks) *(LAS bf16x8*)(Cb + (4 * ks + fq) * 256 + fr * 16) = cr[ks]; \
        if ((hc) + 2 < nhc) DSA_LOADT(cr, (hc) + 2); \
        float sv[4], bz[4]; \
        _Pragma("unroll") for (int r = 0; r < 4; ++r) bz[r] = lut[min(max(t - (int)(unsigned short)ia[r], 0), 127)];     \
        _Pragma("unroll") for (int r = 0; r < 4; ++r) { const float v_ = s0[r] * QSCALE + bz[r]; sv[r] = (16 * (hc) + 4 * fq + r < nsel) ? v_ : -INFINITY; } \
        float mx = fmaxf(fmaxf(sv[0], sv[1]), fmaxf(sv[2], sv[3])); \
        mx = xmax16(mx); mx = xmax32(mx); \
        const float mn = fmaxf(m, mx), alpha = __builtin_amdgcn_exp2f(m - mn); m = mn; \
        float sum = 0.f; \
        _Pragma("unroll") for (int r = 0; r < 4; ++r) { sv[r] = __builtin_amdgcn_exp2f(sv[r] - mn); sum += sv[r]; } \
        l = l * alpha + sum; \
        if (__any(alpha != 1.0f)) { _Pragma("unroll") for (int ct = 0; ct < 16; ++ct) o[ct] = o[ct] * alpha; } \
        pg8::u32x2 pw; pw.x = cvtpk(sv[0], sv[1]); pw.y = cvtpk(sv[2], sv[3]); \
        const s16x4 pb = __builtin_bit_cast(s16x4, pw); \
        _Pragma("unroll") for (int cb = 0; cb < 2; ++cb) { s16x4 tf_[8];                      \
            _Pragma("unroll") for (int c8 = 0; c8 < 8; ++c8) tf_[c8] = __builtin_bit_cast(s16x4, __builtin_amdgcn_ds_read_tr16_b64_v4i16((LAS s16x4*)(rb + (8 * cb + c8) * 512))); \
            __builtin_amdgcn_sched_barrier(0); \
            _Pragma("unroll") for (int c8 = 0; c8 < 8; ++c8) o[8 * cb + c8] = __builtin_amdgcn_mfma_f32_16x16x16bf16_1k(tf_[c8], pb, o[8 * cb + c8], 0, 0, 0); \
            __builtin_amdgcn_sched_barrier(0); } \
    } while (0)
    LAS const unsigned char* rb = Cb + ((fr & 3) >> 1) * 256 + (4 * fq + (fr >> 2)) * 16 + (fr & 1) * 8;
    DSA_LOADT(crA, 0); if (nhc > 1) DSA_LOADT(crB, 1);
    for (int hc = 0; hc < nhc; hc += 2) {
        DSA_TILE(crA, hc);
        if (hc + 1 < nhc) DSA_TILE(crB, hc + 1);
    }
#undef DSA_TILE
#undef DSA_LOADT
    const float lt = xsum16(l); const float ltt = xsum32(lt); const float inv = ltt > 0.f ? 1.0f / ltt : 0.f;
    asm volatile("s_waitcnt lgkmcnt(0)" ::: "memory");
    bf16* op = OLAT + row * 4096 + fr * 256 + 4 * fq;
#pragma unroll
    for (int ct = 0; ct < 16; ++ct) *(GAS unsigned long long*)(op + 16 * ct) = (unsigned long long)pk2(o[ct][0] * inv, o[ct][1] * inv) | ((unsigned long long)pk2(o[ct][2] * inv, o[ct][3] * inv) << 32);
    }
}

__device__ __forceinline__ void p0_prologue(Frame& F, const Args& a) {
    unsigned char* ws = a.ws;
    {
        LAS float* cact = (LAS float*)(F.lds + RING_OFF);
        LAS float* red = (LAS float*)(F.lds + RING_OFF + 32768);
        const float* c = a.in[1];
        for (int i = F.tid; i < NB * D; i += NWAVES * 64) cact[i] = silu_f(c[i]);
        __syncthreads();
        float* MOD = (float*)(ws + WS_MOD);
        const int cg = F.tid & 7, kg = F.tid >> 3;
        constexpr int NIT = DEPTH * (NMOD / 32);
        for (int it = F.vcu; it < NIT; it += F.G) {
            const int l = it / (NMOD / 32), j0 = (it % (NMOD / 32)) * 32;
            const float* W = a.in[2] + (size_t)l * D * NMOD + j0 + 4 * cg;
            f32x4 acc[4] = {{0.f, 0.f, 0.f, 0.f}, {0.f, 0.f, 0.f, 0.f}, {0.f, 0.f, 0.f, 0.f}, {0.f, 0.f, 0.f, 0.f}};
#pragma unroll 16
            for (int kk = 0; kk < 32; ++kk) { const int k = kg * 32 + kk; const f32x4 w = *(const GAS f32x4*)(W + (size_t)k * NMOD);
#pragma unroll
                for (int b = 0; b < 4; ++b) acc[b] += w * cact[b * D + k]; }
#pragma unroll
            for (int b = 0; b < 4; ++b) *(LAS f32x4*)(red + (kg * 4 + b) * 32 + 4 * cg) = acc[b];
            __syncthreads();
            if (F.tid < 128) { const int b = F.tid >> 5, col = F.tid & 31; float sm = 0.f;
#pragma unroll 16
              for (int q = 0; q < 64; ++q) sm += red[(q * 4 + b) * 32 + col];
              MOD[((size_t)l * NB + b) * NMOD + j0 + col] = sm + a.in[3][(size_t)l * NMOD + j0 + col]; }
            __syncthreads();
        }
    }
    LAS float* scr = (LAS float*)(F.lds + RING_OFF + F.wave * 16384);
    const int gw = F.vcu * NWAVES + F.wave, NGW = F.G * NWAVES;
    constexpr int I_FI = (D / 64) * (2 * FF / 64), I_FO = (FF / 64) * (D / 64), I_WIN = (D / 64) * ((NIN + 63) / 64), I_UP = (1024 / 64) * (D / 64), I_WO = (D / 64) * (D / 64);
    constexpr int PER_L = 2 * I_FI + 2 * I_FO + I_WIN + 2 * I_UP + I_WO;
    LAS unsigned* scu = (LAS unsigned*)scr;
    for (int it = gw; it < DEPTH * PER_L; it += NGW) {
        const int l = it / PER_L; int r = it % PER_L;
        if (r < 2 * I_FI) { const int f = r / I_FI; p0_transpose_item64(a.in[5] + ((size_t)l * 2 + f) * D * 2 * FF, D, 2 * FF, (bf16*)(ws + WS_WFI + ((size_t)l * 2 + f) * SZ_WFI1), MapFfnIn(), scu, r % I_FI, F.lane); continue; } r -= 2 * I_FI;
        if (r < 2 * I_FO) { const int f = r / I_FO; p0_transpose_item64(a.in[6] + ((size_t)l * 2 + f) * FF * D, FF, D, (bf16*)(ws + WS_WFO + ((size_t)l * 2 + f) * SZ_WFO1), MapIdent(), scu, r % I_FO, F.lane); continue; } r -= 2 * I_FO;
        if (r < I_WIN) { p0_transpose_item64(a.in[7] + (size_t)l * D * NIN, D, NIN, (bf16*)(ws + WS_WIN + (size_t)l * SZ_WIN1), MapWin(), scu, r, F.lane); continue; } r -= I_WIN;
        if (r < I_UP) { p0_transpose_item64(a.in[17] + (size_t)l * 1024 * D, 1024, D, (bf16*)(ws + WS_WUPN + (size_t)l * 2 * SZ_WUP1), MapIdent(), scu, r, F.lane, 2048, 0); continue; } r -= I_UP;
        if (r < I_UP) { p0_transpose_item64(a.in[18] + (size_t)l * 1024 * D, 1024, D, (bf16*)(ws + WS_WUPN + (size_t)l * 2 * SZ_WUP1), MapIdent(), scu, r, F.lane, 2048, 1024); continue; } r -= I_UP;
        p0_transpose_item64(a.in[19] + (size_t)l * D * D, D, D, (bf16*)(ws + WS_WOUT + (size_t)l * SZ_WOUT1), MapIdent(), scu, r, F.lane);
    }
    for (int l = 0; l < DEPTH; ++l) { GAS v4u* p = (GAS v4u*)(ws + WS_WIN + (size_t)l * SZ_WIN1 + (size_t)4448 * D * 2);
        for (int i = gw * 64 + F.lane; i < 160 * D * 2 / 16; i += NGW * 64) p[i] = (v4u){0u, 0u, 0u, 0u}; }
    { constexpr int I_C1 = (2048 / 64) * (256 / 32), I_C2 = (256 / 64) * (64 / 32), I_UV = (256 / 64) * (1024 / 32), PER = 2 * I_C1 + 2 * I_C2 + I_UV;
      for (int it = gw; it < DEPTH * PER; it += NGW) { const int l = it / PER; int r = it % PER;
        if (r < 2 * I_C1) { const int kv = r / I_C1; p0_transpose_item(a.in[kv ? 12 : 10] + (size_t)l * 2048 * 256, 2048, 256, (bf16*)(ws + WS_WC1) + ((size_t)l * 512 + kv * 256) * 2048, MapIdent(), scr, r % I_C1, F.lane); continue; } r -= 2 * I_C1;
        if (r < 2 * I_C2) { const int kv = r / I_C2; p0_transpose_item(a.in[kv ? 13 : 11] + (size_t)l * 256 * 64, 256, 64, (bf16*)(ws + WS_WC2) + ((size_t)l * 2 + kv) * 64 * 256, MapIdent(), scr, r % I_C2, F.lane); continue; } r -= 2 * I_C2;
        p0_transpose_item(a.in[16] + (size_t)l * 256 * 1024, 256, 1024, (bf16*)(ws + WS_WUVT) + (size_t)l * 1024 * 256, MapIdent(), scr, r, F.lane); } }
    { const float* src = a.in[15]; bf16* dst = (bf16*)(ws + WS_WUK);
      for (int i = gw * 64 + F.lane; i < DEPTH * 256 * 1024 / 4; i += NGW * 64) { const f32x4 v = *(const GAS f32x4*)(src + 4 * (size_t)i);
          *(GAS unsigned long long*)(dst + 4 * (size_t)i) = (unsigned long long)pk2(v.x, v.y) | ((unsigned long long)pk2(v.z, v.w) << 32); } }
    if (F.wave == 0) {
        for (int it = F.vcu; it < DEPTH * 2 * 64; it += F.G) { const int l = it >> 7, kv = (it >> 6) & 1, j0 = (it & 63) * 4;
            const float* pe = a.in[kv ? 9 : 8] + (size_t)l * 2048; const float* w1 = a.in[kv ? 12 : 10] + (size_t)l * 2048 * 256 + j0;
            f32x4 acc = {0.f, 0.f, 0.f, 0.f};
#pragma unroll 8
            for (int i = 0; i < 32; ++i) { const int k = F.lane + 64 * i; const f32x4 wv = *(const GAS f32x4*)(w1 + (size_t)k * 256); acc += wv * pe[k]; }
            f32x4 r; r.x = wave_sum(acc.x); r.y = wave_sum(acc.y); r.z = wave_sum(acc.z); r.w = wave_sum(acc.w);
            if (F.lane == 0) *(GAS f32x4*)((float*)(ws + WS_B1) + (l * 2 + kv) * 256 + j0) = r; }
    }
}

__global__ void __launch_bounds__(NWAVES * 64, 2) mk_fwd(Args args) {
    extern __shared__ __attribute__((aligned(16))) unsigned char lds[];
    Frame F;
    F.lds = (LAS unsigned char*)lds;
    F.MISC = (volatile LAS unsigned*)(F.lds + MISC_OFF);
    F.tid = threadIdx.x; F.lane = F.tid & 63; F.wave = __builtin_amdgcn_readfirstlane(F.tid >> 6);
    F.G = gridDim.x; { const int bx = blockIdx.x; F.vcu = (F.G % 8 == 0) ? (bx % 8) * (F.G / 8) + bx / 8 : bx; }
    unsigned char* ws = args.ws;
    F.ctl = (gu32*)(ws + WS_CTL);
    for (int u = F.tid; u < (LDS_BYTES - LDSCTL_OFF) / 4; u += NWAVES * 64) ((LAS unsigned*)(F.lds + LDSCTL_OFF))[u] = 0u;
    __syncthreads();
    XcdBarrier bar = xcd_barrier_post((unsigned*)(F.ctl + CW_BAR) + args.li * XCD_BAR_WORDS, F.MISC + 8);
    const int lo = args.ph_lo, hi = args.ph_hi;
#define IN(k) (lo <= (k) && (k) < hi)
#define SEAM(k) do { if ((k) + 1 < hi) xcd_barrier(bar, F.wave); } while (0)

    if (IN(0)) { for (int rep = 0; rep < REP_P0; ++rep) { p0_prologue(F, args); if (rep + 1 < REP_P0) __syncthreads(); } SEAM(0); }

    for (int ll = 0; ll < DEPTH * REP_ALL; ++ll) { const int l = ll % DEPTH;
        const int pb = 1 + l * NPL;
        if (PHON(0) && IN(pb + 0)) { unsigned char* w = launder(ws); Frame Fp = refresh(F); const float* xin0 = (l == 0) ? launder(args.in[0]) : (const float*)(w + WS_X);
            for (int rep = 0; rep < REP_MOD; ++rep) modulate_phase(Fp, xin0, (bf16*)(w + WS_H), launder(args.in[4]) + (size_t)l * 3 * D, (const float*)(w + WS_MOD) + (size_t)l * NB * NMOD); SEAM(pb + 0); }
        if (PHON(1) && IN(pb + 1)) { unsigned char* w = launder(ws); Frame Fp = refresh(F);
            pg8::Gemm g{(const bf16*)(w + WS_H), (const bf16*)(w + WS_WFI + ((size_t)l * 2 + 0) * SZ_WFI1), M, 2 * FF, D, D, D}; pg8::StaticOrder S; S.init(M, 2 * FF, Fp.G, (int)blockIdx.x);
            EpiSwiglu E{(bf16*)(w + WS_ACT)};
            for (int rep = 0; rep < REP_FFI; ++rep) pg8::gemm_phase<EpiSwiglu, pg8::StaticOrder, true, true>(Fp.lds + RING_OFF, g, S, E, Fp.wave);
            SEAM(pb + 1);
        }
        if (PHON(2) && IN(pb + 2)) { unsigned char* w = launder(ws); Frame Fp = refresh(F); const float* xin0 = (l == 0) ? launder(args.in[0]) : (const float*)(w + WS_X);
            pg8::Gemm g{(const bf16*)(w + WS_ACT), (const bf16*)(w + WS_WFO + ((size_t)l * 2 + 0) * SZ_WFO1), M, D, FF, FF, FF}; pg8::StaticOrder S; S.init(M, D, Fp.G, (int)blockIdx.x);
            EpiResid E{xin0, (float*)(w + WS_X), (const float*)(w + WS_MOD) + (size_t)l * NB * NMOD + 2 * D, 0.5f};
            for (int rep = 0; rep < (l == 0 ? REP_FFO : 1); ++rep) pg8::gemm_phase<EpiResid, pg8::StaticOrder, true, true>(Fp.lds + RING_OFF, g, S, E, Fp.wave);
            SEAM(pb + 2);
        }
        if (PHON(3) && IN(pb + 3)) { unsigned char* w = launder(ws); Frame Fp = refresh(F);
            for (int rep = 0; rep < REP_MOD; ++rep) modulate_phase(Fp, (const float*)(w + WS_X), (bf16*)(w + WS_H), launder(args.in[4]) + (size_t)l * 3 * D + D, (const float*)(w + WS_MOD) + (size_t)l * NB * NMOD + 3 * D); SEAM(pb + 3); }
        if (PHON(4) && IN(pb + 4)) { unsigned char* w = launder(ws); Frame Fp = refresh(F);
            pg8::Gemm g{(const bf16*)(w + WS_H), (const bf16*)(w + WS_WIN + (size_t)l * SZ_WIN1), M, NINP, D, D, D}; pg8::StaticOrder S; S.init(M, NINP, Fp.G, (int)blockIdx.x);
            EpiWin E{w};
            for (int rep = 0; rep < REP_WIN; ++rep) pg8::gemm_phase<EpiWin, pg8::StaticOrder, true, true>(Fp.lds + RING_OFF, g, S, E, Fp.wave);
            SEAM(pb + 4);
        }
        if (PHON(5) && IN(pb + 5)) { unsigned char* w = launder(ws); Frame Fp = refresh(F);
            const int ncmp = Fp.G > 64 ? 32 : 0;
            if (Fp.vcu < ncmp || ncmp == 0) {
                pg8::Gemm g{(const bf16*)(w + WS_KV), (const bf16*)(w + WS_WC1 + (size_t)l * 512 * 2048 * 2), 8192, 512, 2048, 1024, 2048}; CmpOrder S{ncmp ? ncmp : Fp.G, Fp.vcu};
                EpiCmp1 E{(bf16*)(w + WS_CMPH), (const float*)(w + WS_B1) + l * 512};
                pg8::gemm_phase<EpiCmp1, CmpOrder, true, true>(Fp.lds + RING_OFF, g, S, E, Fp.wave);
                if (ncmp) cmp2_items((const bf16*)(w + WS_CMPH), (const bf16*)(w + WS_WC2) + (size_t)l * 2 * 64 * 256, (bf16*)(w + WS_KCMP), Fp.vcu * 16, Fp.vcu * 16 + 16, Fp.wave, NWAVES, Fp.lane);
            }
            if (Fp.vcu >= ncmp) { const int w0 = (Fp.vcu - ncmp) * NWAVES + Fp.wave, nw = (Fp.G - ncmp) * NWAVES;
                for (int rep = 0; rep < REP_THIN; ++rep) ckvnorm_rows((const float*)(w + WS_CKVR), (bf16*)(w + WS_CKVN), launder(args.in[14]) + l * 256, w0, nw, Fp.lane);
                for (int rep = 0; rep < REP_THIN; ++rep) qlat_items((const bf16*)(w + WS_QD), (const bf16*)(w + WS_WUK) + (size_t)l * 256 * 1024, (bf16*)(w + WS_QLAT), (Fp.vcu - ncmp) >> 1, (Fp.G - ncmp) >> 1, (Fp.vcu - ncmp) & 1, Fp.wave, Fp.lane); }
            SEAM(pb + 5);
        }
        if (PHON(6) && IN(pb + 6) && !(F.G > 64)) { unsigned char* w = launder(ws); Frame Fp = refresh(F);
            for (int kvh = 0; kvh < 2; ++kvh) cmp2_items((const bf16*)(w + WS_CMPH), (const bf16*)(w + WS_WC2) + (size_t)l * 2 * 64 * 256, (bf16*)(w + WS_KCMP), 256 * kvh, 256 * kvh + 256, Fp.vcu * NWAVES + Fp.wave, Fp.G * NWAVES, Fp.lane);
            SEAM(pb + 6);
        }
        if (PHON(7) && IN(pb + 7)) { unsigned char* w = launder(ws); Frame Fp = refresh(F);
            build_luts(Fp, launder(args.in[20]));
            if (Fp.G == 256) {
                const int b = Fp.vcu >> 6, g = (Fp.vcu >> 4) & 3, s = Fp.vcu & 15; int itc = 0;
#pragma unroll 1
                for (int qq = 0; qq < 4 * REP_NSA; ++qq) { const int q = qq & 3; const int i = (q == 0) ? s : (q == 1) ? 31 - s : (q == 2) ? 32 + s : 63 - s;
#ifndef NO_NSA
                    nsa_unit(Fp, b, g, i, (const bf16*)(w + WS_QN), (const bf16*)(w + WS_KV), (const bf16*)(w + WS_KCMP), (const float*)(w + WS_GN), (bf16*)(w + WS_ON), itc);
#endif
                }
                __syncthreads();
                const int j = (Fp.vcu & 63) * NWAVES + Fp.wave;
#pragma unroll 1
                for (int kk = 0; kk < 8 * REP_DSA; ++kk) { const int k = (Fp.wave & 4) ? 7 - (kk & 7) : (kk & 7); const int t = 512 * k + ((k & 1) ? 511 - j : j);
#ifndef NO_DSA
                    dsa_token(Fp, b, t, (const bf16*)(w + WS_QI), (const bf16*)(w + WS_KI), (const float*)(w + WS_WI), (const bf16*)(w + WS_CKVN), (const bf16*)(w + WS_QLAT), (bf16*)(w + WS_OLAT));
#endif
                }
            }
            SEAM(pb + 7);
        }
        if (PHON(8) && IN(pb + 8)) { unsigned char* w = launder(ws); Frame Fp = refresh(F);
            for (int rep = 0; rep < REP_THIN; ++rep) od_items((const bf16*)(w + WS_OLAT), (const bf16*)(w + WS_WUVT) + (size_t)l * 1024 * 256, (bf16*)(w + WS_ON), Fp.vcu, Fp.G, Fp.wave, Fp.lane);
            SEAM(pb + 8);
        }
        if (PHON(9) && IN(pb + 9)) { unsigned char* w = launder(ws); Frame Fp = refresh(F);
            pg8::Gemm g{(const bf16*)(w + WS_ON), (const bf16*)(w + WS_WUPN + (size_t)l * 2 * SZ_WUP1), M, D, 2048, 2048, 2048}; pg8::StaticOrder S; S.init(M, D, Fp.G, (int)blockIdx.x);
            EpiUpF E{(const bf16*)(w + WS_AM), (bf16*)(w + WS_Y)};
            pg8::gemm_phase<EpiUpF, pg8::StaticOrder, true, true>(Fp.lds + RING_OFF, g, S, E, Fp.wave);
            SEAM(pb + 9);
        }
        if (PHON(10) && IN(pb + 10)) { unsigned char* w = launder(ws); Frame Fp = refresh(F);
            pg8::Gemm g{(const bf16*)(w + WS_Y), (const bf16*)(w + WS_WOUT + (size_t)l * SZ_WOUT1), M, D, D, D, D}; pg8::StaticOrder S; S.init(M, D, Fp.G, (int)blockIdx.x);
            EpiResid E{(const float*)(w + WS_X), (float*)(w + WS_X), (const float*)(w + WS_MOD) + (size_t)l * NB * NMOD + 3 * D + 2 * D, 1.0f};
            pg8::gemm_phase<EpiResid, pg8::StaticOrder, true, true>(Fp.lds + RING_OFF, g, S, E, Fp.wave);
            SEAM(pb + 10);
        }
        if (PHON(11) && IN(pb + 11)) { unsigned char* w = launder(ws); Frame Fp = refresh(F);
            for (int rep = 0; rep < REP_MOD; ++rep) modulate_phase(Fp, (const float*)(w + WS_X), (bf16*)(w + WS_H), launder(args.in[4]) + (size_t)l * 3 * D + 2 * D, (const float*)(w + WS_MOD) + (size_t)l * NB * NMOD + 2 * 3 * D); SEAM(pb + 11); }
        if (PHON(12) && IN(pb + 12)) { unsigned char* w = launder(ws); Frame Fp = refresh(F);
            pg8::Gemm g{(const bf16*)(w + WS_H), (const bf16*)(w + WS_WFI + ((size_t)l * 2 + 1) * SZ_WFI1), M, 2 * FF, D, D, D}; pg8::StaticOrder S; S.init(M, 2 * FF, Fp.G, (int)blockIdx.x);
            EpiSwiglu E{(bf16*)(w + WS_ACT)};
            for (int rep = 0; rep < REP_FFI; ++rep) pg8::gemm_phase<EpiSwiglu, pg8::StaticOrder, true, true>(Fp.lds + RING_OFF, g, S, E, Fp.wave);
            SEAM(pb + 12);
        }
        if (PHON(13) && IN(pb + 13)) { unsigned char* w = launder(ws); Frame Fp = refresh(F);
            pg8::Gemm g{(const bf16*)(w + WS_ACT), (const bf16*)(w + WS_WFO + ((size_t)l * 2 + 1) * SZ_WFO1), M, D, FF, FF, FF}; pg8::StaticOrder S; S.init(M, D, Fp.G, (int)blockIdx.x);
            EpiResid E{(const float*)(w + WS_X), (float*)(w + WS_X), (const float*)(w + WS_MOD) + (size_t)l * NB * NMOD + 2 * 3 * D + 2 * D, 0.5f};
            pg8::gemm_phase<EpiResid, pg8::StaticOrder, true, true>(Fp.lds + RING_OFF, g, S, E, Fp.wave);
            SEAM(pb + 13);
        }
    }
    if (IN(NPH - 1)) { unsigned char* w = launder(ws); Frame Fp = refresh(F); final_norm_phase(Fp, (const float*)(w + WS_X), launder(args.out), launder(args.in[21])); }
#undef IN
#undef SEAM
}

extern "C" void kernel_launch(void* const* d_in, const int* in_sizes, int n_in, void* d_out, int out_size, void* d_ws, size_t ws_size, hipStream_t stream) {
    static int grid = 0;
    if (grid == 0) {
        if (n_in != 22 || out_size != M * D || ws_size < WS_END) { fprintf(stderr, "kernel_launch: unexpected shapes (n_in %d, out %d, ws %zu < %zu)\n", n_in, out_size, ws_size, (size_t)WS_END); grid = -1; return; }
        int dev = 0, cus = 0, per_cu = 0;
        if (hipGetDevice(&dev) != hipSuccess || hipDeviceGetAttribute(&cus, hipDeviceAttributeMultiprocessorCount, dev) != hipSuccess) { grid = -1; return; }
        if (hipFuncSetAttribute((const void*)mk_fwd, hipFuncAttributeMaxDynamicSharedMemorySize, LDS_BYTES) != hipSuccess) { fprintf(stderr, "kernel_launch: hipFuncSetAttribute failed\n"); grid = -1; return; }
        if (hipOccupancyMaxActiveBlocksPerMultiprocessor(&per_cu, (const void*)mk_fwd, NWAVES * 64, LDS_BYTES) != hipSuccess || per_cu < 1) fprintf(stderr, "kernel_launch: occupancy query says %d\n", per_cu);
        (void)hipGetLastError();
        grid = cus;
    }
    if (grid < 0) return;
    (void)hipMemsetAsync((char*)d_ws + WS_CTL, 0, CTL_ZERO_BYTES, stream);
    Args a{};
    for (int i = 0; i < 22; ++i) a.in[i] = (const float*)d_in[i];
    a.out = (float*)d_out; a.ws = (unsigned char*)d_ws;
    a.ph_lo = 0; a.ph_hi = NPH; a.li = 0; a.pad = 0;
    hipLaunchKernelGGL(mk_fwd, dim3(grid), dim3(NWAVES * 64), LDS_BYTES, stream, a);
}
```
